# Optimizing an MI355X kernel written in HIP

```python
import jax, jax.numpy as jnp
from jax import lax
import numpy as np

D_MODEL = 1024
BATCH = 8
SEQ = 2048
DEPTH = 2
DEC_BATCH = 32
DEC_SEQ = 4
PAST_LEN = 8192
PAGE_SIZE = 128

HEAD_DIM = 64
HEADS_PER_GROUP = 4
WINDOWS = (128, 512, 2048)
DILATIONS = (1, 4, 16)
N_GROUPS = 3
N_ATT_HEADS = N_GROUPS * HEADS_PER_GROUP
ATT_WIDTH = N_ATT_HEADS * HEAD_DIM
MERGED_ATT_WIDTH = HEADS_PER_GROUP * HEAD_DIM
CHUNK = 128
GMLP_GROUPS = 4
GMLP_WIDTH = D_MODEL // 2
GMLP_GROUP_CH = GMLP_WIDTH // GMLP_GROUPS
D_FF = 2816
IN_WIDTH = 3 * ATT_WIDTH + 2 * GMLP_WIDTH + 2 * D_MODEL
SPLITS = (ATT_WIDTH, 2 * ATT_WIDTH, 3 * ATT_WIDTH,
          3 * ATT_WIDTH + GMLP_WIDTH, 3 * ATT_WIDTH + 2 * GMLP_WIDTH,
          3 * ATT_WIDTH + 2 * GMLP_WIDTH + D_MODEL)
EPS = 1e-6
NEG_INF = -1e30

kernel_name = 'hybrid_dilated_attn_gmlp_decode_step'


def rmsnorm(x, gain):
    xf = x.astype(jnp.float32)
    r = lax.rsqrt(jnp.mean(xf * xf, axis=-1, keepdims=True) + EPS)
    return (xf * r).astype(x.dtype) * gain


def swiglu_half_step(x, norm, w_gate, w_up, w_down):
    h = rmsnorm(x, norm)
    return x + 0.5 * ((jax.nn.silu(h @ w_gate) * (h @ w_up)) @ w_down)


def alibi_slopes():
    h = np.arange(1, N_ATT_HEADS + 1, dtype=np.float32)
    return np.power(np.float32(2.0), -8.0 * h / N_ATT_HEADS).astype(np.float32).reshape(N_GROUPS, HEADS_PER_GROUP)


def dilated_attn_prompt(q, k, v, window, dilation, slopes):
    B, S, H, E = q.shape
    K = window // dilation
    span = dilation * K
    s_pad = -(-S // span) * span
    n = s_pad // dilation
    nb = n // K

    def to_blocks(t):
        t = jnp.pad(t, ((0, 0), (0, s_pad - S), (0, 0), (0, 0)))
        t = t.reshape(B, n, dilation, H, E).transpose(0, 2, 1, 3, 4)
        return t.reshape(B, dilation, nb, K, H, E)

    def with_prev(t):
        prev = jnp.pad(t[:, :, :-1], ((0, 0), (0, 0), (1, 0), (0, 0), (0, 0), (0, 0)))
        return jnp.concatenate([prev, t], axis=3)

    qb = to_blocks(q)
    kb = with_prev(to_blocks(k))
    vb = with_prev(to_blocks(v))
    a = jnp.arange(K)[:, None]
    c = jnp.arange(2 * K)[None, :]
    dist = K + a - c
    blk = jnp.arange(nb)[:, None, None]
    valid = (dist >= 0) & (dist <= K) & ((blk > 0) | (c >= K)[None])
    bias = -slopes[None, :, None] * (dilation * dist)[:, None, :]
    s = jnp.einsum('brnqhe,brnkhe->brnqhk', qb, kb).astype(jnp.float32) * (HEAD_DIM ** -0.5)
    s = jnp.where(valid[None, None, :, :, None, :], s + bias[None, None, None], NEG_INF)
    m = jnp.max(s, axis=-1, keepdims=True)
    p = jnp.exp(s - m)
    l = jnp.sum(p, axis=-1)
    lse = m[..., 0] + jnp.log(l)
    o = jnp.einsum('brnqhk,brnkhe->brnqhe', p.astype(v.dtype), vb) / l[..., None].astype(v.dtype)
    o = o.reshape(B, dilation, n, H, E).transpose(0, 2, 1, 3, 4).reshape(B, s_pad, H, E)[:, :S]
    lse = lse.reshape(B, dilation, n, H).transpose(0, 2, 1, 3).reshape(B, s_pad, H)[:, :S]
    return o, lse


def dilated_attn_sample(q, k_ext, v_ext, past_rows, window, dilation, slopes):
    T = q.shape[1]
    K = window // dilation
    steps = jnp.arange(K + 1) * dilation
    idx = past_rows + jnp.arange(T)[:, None] - steps[None, :]
    valid = idx >= 0
    idx_c = jnp.clip(idx, 0)
    kg = k_ext[:, idx_c]
    vg = v_ext[:, idx_c]
    bias = -slopes[:, None] * steps[None, :]
    s = jnp.einsum('bthe,btkhe->bthk', q, kg).astype(jnp.float32) * (HEAD_DIM ** -0.5)
    s = jnp.where(valid[None, :, None, :], s + bias[None, None], NEG_INF)
    m = jnp.max(s, axis=-1, keepdims=True)
    p = jnp.exp(s - m)
    l = jnp.sum(p, axis=-1)
    lse = m[..., 0] + jnp.log(l)
    o = jnp.einsum('bthk,btkhe->bthe', p.astype(v_ext.dtype), vg) / l[..., None].astype(v_ext.dtype)
    return o, lse


def combine_groups(outs, lses):
    o = jnp.stack(outs, axis=0)
    w = jax.nn.softmax(jnp.stack(lses, axis=0), axis=0)
    return jnp.sum(w[..., None] * o.astype(jnp.float32), axis=0).astype(o.dtype)


def chunk_gmlp(u, vs, w_s, b_s):
    B, T, _ = u.shape
    t_pad = -(-T // CHUNK) * CHUNK
    mask = jnp.tril(jnp.ones((CHUNK, CHUNK), dtype=bool))
    ws = jnp.where(mask[None], w_s, jnp.zeros((), w_s.dtype))
    vb = jnp.pad(vs, ((0, 0), (0, t_pad - T), (0, 0)))
    vb = vb.reshape(B, t_pad // CHUNK, CHUNK, GMLP_GROUPS, GMLP_GROUP_CH)
    z = jnp.einsum('gts,bnsgc->bntgc', ws, vb) + b_s.T[None, None, :, :, None]
    z = z.reshape(B, t_pad, GMLP_WIDTH)[:, :T]
    return u * z


def mixer_inputs(h, w_in, v_norm):
    z = h @ w_in
    q, k, v, u, vs, ga, gb = jnp.split(z, SPLITS, axis=-1)
    shp = h.shape[:-1] + (N_GROUPS, HEADS_PER_GROUP, HEAD_DIM)
    return (q.reshape(shp), k.reshape(shp), v.reshape(shp),
            jax.nn.gelu(u), rmsnorm(jax.nn.gelu(vs), v_norm),
            jax.nn.sigmoid(ga), jax.nn.sigmoid(gb))


def token_mixing(x, mix_norm, w_in, v_norm, w_s, b_s, proj_att, proj_spatial, w_out, past_kv):
    h = rmsnorm(x, mix_norm)
    q, k, v, u, vs, ga, gb = mixer_inputs(h, w_in, v_norm)
    slopes = alibi_slopes()
    outs, lses, new_kv = [], [], []
    for g in range(N_GROUPS):
        qg, kg, vg = q[:, :, g], k[:, :, g], v[:, :, g]
        if past_kv is None:
            o, lse = dilated_attn_prompt(qg, kg, vg, WINDOWS[g], DILATIONS[g], slopes[g])
            keep = min(WINDOWS[g], x.shape[1])
            new_kv.append(jnp.stack([kg[:, -keep:], vg[:, -keep:]], axis=2))
        else:
            buf = past_kv[g]
            k_ext = jnp.concatenate([buf[:, :, 0], kg], axis=1)
            v_ext = jnp.concatenate([buf[:, :, 1], vg], axis=1)
            o, lse = dilated_attn_sample(qg, k_ext, v_ext, buf.shape[1], WINDOWS[g], DILATIONS[g], slopes[g])
            new_kv.append(jnp.stack([kg, vg], axis=2))
        outs.append(o)
        lses.append(lse)
    att = combine_groups(outs, lses)
    att = att.reshape(att.shape[:2] + (MERGED_ATT_WIDTH,))
    spat = chunk_gmlp(u, vs, w_s, b_s)
    out = (ga * (att @ proj_att) + gb * (spat @ proj_spatial)) @ w_out
    return x + out, new_kv, vs


def setup_inputs(seed: int = 0) -> dict:
    key = jax.random.key(seed)
    ks = iter(jax.random.split(key, 32))

    def nrm(shape, scale):
        return scale * jax.random.normal(next(ks), shape, jnp.float32)

    def gain(shape):
        return 1.0 + 0.01 * jax.random.normal(next(ks), shape, jnp.float32)

    inputs = {
        'x_prompt': nrm((BATCH, SEQ, D_MODEL), 1.0),
        'x_sample': nrm((DEC_BATCH, DEC_SEQ, D_MODEL), 1.0),
    }
    for w in WINDOWS:
        rows = min(w, PAST_LEN)
        inputs['cache_kv_w%d' % w] = nrm((DEPTH, DEC_BATCH, rows, 2, HEADS_PER_GROUP, HEAD_DIM), 1.0)
    inputs['ffn1_norm'] = gain((DEPTH, D_MODEL))
    inputs['ffn1_gate'] = nrm((DEPTH, D_MODEL, D_FF), D_MODEL ** -0.5)
    inputs['ffn1_up'] = nrm((DEPTH, D_MODEL, D_FF), D_MODEL ** -0.5)
    inputs['ffn1_down'] = nrm((DEPTH, D_FF, D_MODEL), D_FF ** -0.5)
    inputs['mix_norm'] = gain((DEPTH, D_MODEL))
    inputs['w_in'] = nrm((DEPTH, D_MODEL, IN_WIDTH), D_MODEL ** -0.5)
    inputs['gmlp_v_norm'] = gain((DEPTH, GMLP_WIDTH))
    inputs['gmlp_ws'] = nrm((DEPTH, GMLP_GROUPS, CHUNK, CHUNK), CHUNK ** -0.5)
    inputs['gmlp_bias'] = 1.0 + nrm((DEPTH, GMLP_GROUPS, CHUNK), 0.1)
    inputs['proj_att'] = nrm((DEPTH, MERGED_ATT_WIDTH, D_MODEL), MERGED_ATT_WIDTH ** -0.5)
    inputs['proj_spatial'] = nrm((DEPTH, GMLP_WIDTH, D_MODEL), GMLP_WIDTH ** -0.5)
    inputs['w_out'] = nrm((DEPTH, D_MODEL, D_MODEL), D_MODEL ** -0.5)
    inputs['ffn2_norm'] = gain((DEPTH, D_MODEL))
    inputs['ffn2_gate'] = nrm((DEPTH, D_MODEL, D_FF), D_MODEL ** -0.5)
    inputs['ffn2_up'] = nrm((DEPTH, D_MODEL, D_FF), D_MODEL ** -0.5)
    inputs['ffn2_down'] = nrm((DEPTH, D_FF, D_MODEL), D_FF ** -0.5)
    inputs['final_norm'] = gain((D_MODEL,))
    return inputs


def reference(x_prompt, x_sample, cache_kv_w128, cache_kv_w512, cache_kv_w2048,
              ffn1_norm, ffn1_gate, ffn1_up, ffn1_down, mix_norm, w_in, gmlp_v_norm,
              gmlp_ws, gmlp_bias, proj_att, proj_spatial, w_out,
              ffn2_norm, ffn2_gate, ffn2_up, ffn2_down, final_norm):
    caches = (cache_kv_w128, cache_kv_w512, cache_kv_w2048)
    xp, xs = x_prompt, x_sample
    kv_p = [[] for _ in range(N_GROUPS)]
    kv_s = [[] for _ in range(N_GROUPS)]
    gv_s = []
    for l in range(DEPTH):
        mix_w = (mix_norm[l], w_in[l], gmlp_v_norm[l], gmlp_ws[l], gmlp_bias[l],
                 proj_att[l], proj_spatial[l], w_out[l])
        xp = swiglu_half_step(xp, ffn1_norm[l], ffn1_gate[l], ffn1_up[l], ffn1_down[l])
        xp, new_p, _ = token_mixing(xp, *mix_w, None)
        xp = swiglu_half_step(xp, ffn2_norm[l], ffn2_gate[l], ffn2_up[l], ffn2_down[l])
        xs = swiglu_half_step(xs, ffn1_norm[l], ffn1_gate[l], ffn1_up[l], ffn1_down[l])
        xs, new_s, vs_s = token_mixing(xs, *mix_w, (caches[0][l], caches[1][l], caches[2][l]))
        xs = swiglu_half_step(xs, ffn2_norm[l], ffn2_gate[l], ffn2_up[l], ffn2_down[l])
        for g in range(N_GROUPS):
            kv_p[g].append(new_p[g])
            kv_s[g].append(new_s[g])
        gv_s.append(vs_s)
    y_prompt = rmsnorm(xp, final_norm)
    y_sample = rmsnorm(xs, final_norm)
    kv_w128_prompt = jnp.stack(kv_p[0], axis=0)
    kv_w512_prompt = jnp.stack(kv_p[1], axis=0)
    kv_w2048_prompt = jnp.stack(kv_p[2], axis=0)
    kv_w128_sample = jnp.stack(kv_s[0], axis=0)
    kv_w512_sample = jnp.stack(kv_s[1], axis=0)
    kv_w2048_sample = jnp.stack(kv_s[2], axis=0)
    gmlp_v_sample = jnp.stack(gv_s, axis=0)
    return (y_prompt, y_sample, kv_w128_prompt, kv_w512_prompt, kv_w2048_prompt,
            kv_w128_sample, kv_w512_sample, kv_w2048_sample, gmlp_v_sample)
```

```cpp
#include <hip/hip_runtime.h>
#include <hip/hip_cooperative_groups.h>
#include <cstdio>
#include <cstdint>
namespace cg = cooperative_groups;
namespace pg8 {
#define PG8_LAS __attribute__((address_space(3)))
typedef unsigned short bf16_t;
typedef short bf16x8 __attribute__((ext_vector_type(8)));
typedef float f32x4 __attribute__((ext_vector_type(4)));
typedef unsigned u32x4 __attribute__((ext_vector_type(4)));
constexpr int BM = 256, BK = 64, HALF = 128, HTB = HALF * BK * 2  , STAGE_BYTES = 8 * HTB, NXCD = 8, WGM = 8;

__host__ __device__ __forceinline__ int lds_byte(int r, int c) { const int st = (r >> 4) * 2 + (c >> 5), rr = r & 15, cc = c & 31, ob = rr * 64 + cc * 2; return st * 1024 + (ob ^ (((ob >> 9) & 1) << 5)); }
__host__ __device__ __forceinline__ void stage_rc(int b, int& R, int& C) { const int st = b / 1024, sb = b % 1024, swz = sb ^ (((sb >> 9) & 1) << 5); R = (st >> 1) * 16 + swz / 64; C = (st & 1) * 32 + (swz % 64) / 2; }
__host__ __device__ __forceinline__ int perm32(int rho) { const int n = rho >> 4, i = rho & 15; return 8 * (i >> 2) + 4 * n + (i & 3); }

struct Unit { int pm, pn; };
struct Gemm { const bf16_t* A; const bf16_t* Bt; int M, N, K; };

struct StaticOrder {
    int nM, nN, nwg, G, c;
    __host__ __device__ void init(int M, int N, int G_, int c_) { nM = M / BM; nN = N / BM; nwg = nM * nN; G = G_; c = c_; }
    __host__ __device__ bool next(int i, Unit& u) const {
        const long L = (long)i * G + c; if (L >= nwg) return false;
        int wgid = (int)L; { const int q = nwg / NXCD, r = nwg % NXCD, xcd = wgid % NXCD, off = wgid / NXCD; wgid = (xcd < r ? xcd * (q + 1) : r * (q + 1) + (xcd - r) * q) + off; }
        const int nig = WGM * nN, gid = wgid / nig, fm = gid * WGM, gsz = (nM - fm) < WGM ? (nM - fm) : WGM;
        u.pm = fm + ((wgid % nig) % gsz); u.pn = (wgid % nig) / gsz; return true;
    }
    __device__ __forceinline__ void a_ready(const Unit&) const {}
    __device__ __forceinline__ void done(const Unit&) const {}
};

__device__ __forceinline__ unsigned cvt_pk_bf16(float lo, float hi) { unsigned r; asm volatile("v_cvt_pk_bf16_f32 %0, %1, %2" : "=v"(r) : "v"(lo), "v"(hi)); return r; }
typedef float f32x2 __attribute__((ext_vector_type(2)));
template <class Epi, class Sched, bool ALIGN_EPI = false, bool SP2 = false>
__device__ __forceinline__ void gemm_phase(PG8_LAS unsigned char* lds, const Gemm g, const Sched& S, const Epi& E) {
    int tid_ = threadIdx.x; asm volatile("" : "+v"(tid_));
    const int tid = tid_, wid = __builtin_amdgcn_readfirstlane(tid >> 6), lane = tid & 63, wr = wid >> 2, wc = wid & 3, fr = lane & 15, fq = lane >> 4;
    int K_ = g.K; asm volatile("" : "+s"(K_));
    const int K = K_, nt = K / BK;
    unsigned voffA[2], voffB[2];
#pragma unroll
    for (int i = 0; i < 2; ++i) { int R, C; stage_rc(tid * 16 + i * 8192, R, C); const int Rb = Epi::PERM ? ((R & ~31) + perm32(R & 31)) : R;
        voffA[i] = (unsigned)(R * K + C) * 2u; voffB[i] = (unsigned)(Rb * K + C) * 2u; }
    const size_t kstep = (size_t)(BK * 2);
    const size_t hstep = (size_t)HALF * K * 2;
    const size_t tstep = 2 * hstep;
    const unsigned ldsw = (unsigned)wid * 1024u;
    const int aoff = lds_byte(wr * 64 + fr, fq * 8), boff = lds_byte(wc * 32 + fr, fq * 8);
#define PG8_SA(b, h) (((b) * 2 + (h)) * HTB)
#define PG8_SB(b, h) ((4 + (b) * 2 + (h)) * HTB)
#define PG8_STAGE(bufoff, gbase, voff) do { _Pragma("unroll") for (int _i = 0; _i < 2; ++_i) \
        __builtin_amdgcn_global_load_lds((const unsigned*)((const char*)(gbase) + (voff)[_i]), (PG8_LAS unsigned*)(lds + (bufoff) + ldsw + _i * 8192), 16, 0, 0); } while (0)
#define PG8_LDA(dst, b, h) do { _Pragma("unroll") for (int m = 0; m < 4; ++m) _Pragma("unroll") for (int k = 0; k < 2; ++k) dst[m][k] = *(const PG8_LAS bf16x8*)(lds + PG8_SA(b, h) + aoff + m * 2048 + k * 1024); } while (0)
#define PG8_LDB(dst, b, h) do { _Pragma("unroll") for (int n = 0; n < 2; ++n) _Pragma("unroll") for (int k = 0; k < 2; ++k) dst[n][k] = *(const PG8_LAS bf16x8*)(lds + PG8_SB(b, h) + boff + n * 2048 + k * 1024); } while (0)
#define PG8_MMA(ai, bj, At, Bt) do { __builtin_amdgcn_s_setprio(1); _Pragma("unroll") for (int m = 0; m < 4; ++m) _Pragma("unroll") for (int n = 0; n < 2; ++n) _Pragma("unroll") for (int k = 0; k < 2; ++k) \
        acc[ai][bj][m][n] = __builtin_amdgcn_mfma_f32_16x16x32_bf16(Bt[n][k], At[m][k], acc[ai][bj][m][n], 0, 0, 0); __builtin_amdgcn_s_setprio(0); } while (0)
#define PG8_WAIT_V(n) asm volatile("s_waitcnt vmcnt(" #n ")" ::: "memory")
#define PG8_WAIT_L(n) asm volatile("s_waitcnt lgkmcnt(" #n ")" ::: "memory")
#define PG8_BAR __builtin_amdgcn_s_barrier()
#define PG8_SCHED __builtin_amdgcn_sched_barrier(0)
    Unit cur, nxt; int ui = 0;
    if (!S.next(0, cur)) return;
    f32x4 acc[2][2][4][2];
#pragma unroll
    for (int a = 0; a < 2; ++a)
#pragma unroll
        for (int b = 0; b < 2; ++b)
#pragma unroll
            for (int m = 0; m < 4; ++m)
#pragma unroll
                for (int n = 0; n < 2; ++n) acc[a][b][m][n] = (f32x4){0.f, 0.f, 0.f, 0.f};
    bf16x8 At[4][2], B0[2][2], B1[2][2];
    const char* cA = (const char*)g.A + (size_t)cur.pm * tstep; const char* cB = (const char*)g.Bt + (size_t)cur.pn * tstep;
    S.a_ready(cur);
    if constexpr (SP2) {
        PG8_STAGE(PG8_SB(0, 0), cB, voffB); PG8_STAGE(PG8_SB(0, 1), cB + hstep, voffB); PG8_STAGE(PG8_SA(0, 0), cA, voffA); PG8_STAGE(PG8_SA(0, 1), cA + hstep, voffA);
        if (wr == 1) PG8_BAR;
        PG8_WAIT_V(2); PG8_BAR;
        PG8_STAGE(PG8_SB(1, 0), cB + kstep, voffB); PG8_STAGE(PG8_SA(1, 0), cA + kstep, voffA); PG8_STAGE(PG8_SB(1, 1), cB + hstep + kstep, voffB);
        PG8_WAIT_V(6); PG8_BAR;
    } else {
        PG8_STAGE(PG8_SB(0, 0), cB, voffB); PG8_STAGE(PG8_SA(0, 0), cA, voffA); PG8_STAGE(PG8_SB(0, 1), cB + hstep, voffB); PG8_STAGE(PG8_SA(0, 1), cA + hstep, voffA);
        if (wr == 1) PG8_BAR;
        PG8_WAIT_V(4); PG8_BAR;
        PG8_STAGE(PG8_SB(1, 0), cB + kstep, voffB); PG8_STAGE(PG8_SA(1, 0), cA + kstep, voffA); PG8_STAGE(PG8_SB(1, 1), cB + hstep + kstep, voffB);
        PG8_WAIT_V(6); PG8_BAR;
    }
    for (;;) {
        const bool has_next = S.next(ui + 1, nxt);
        const char* nA = has_next ? (const char*)g.A + (size_t)nxt.pm * tstep : cA; const char* nB = has_next ? (const char*)g.Bt + (size_t)nxt.pn * tstep : cB;
        for (int t = 0; t < nt; t += 2) {
            const bool last = (t == nt - 2);
            const char* a1 = cA + (size_t)(t + 1) * kstep;
            const char* a2 = last ? nA : cA + (size_t)(t + 2) * kstep; const char* b2 = last ? nB : cB + (size_t)(t + 2) * kstep;
            const char* a3 = a2 + kstep; const char* b3 = b2 + kstep;
            if (last && has_next) S.a_ready(nxt);
            if constexpr (SP2) {
            PG8_LDB(B0, 0, 0); PG8_LDB(B1, 0, 1); PG8_SCHED; PG8_LDA(At, 0, 0); PG8_STAGE(PG8_SA(1, 1), a1 + hstep, voffA);
            PG8_WAIT_V(8); PG8_WAIT_L(0); PG8_BAR; PG8_MMA(0, 0, At, B0); PG8_MMA(0, 1, At, B1); PG8_BAR; PG8_SCHED;
            PG8_LDA(At, 0, 1); PG8_STAGE(PG8_SB(0, 0), b2, voffB); PG8_STAGE(PG8_SB(0, 1), b2 + hstep, voffB); PG8_STAGE(PG8_SA(0, 0), a2, voffA);
            PG8_WAIT_V(8); PG8_WAIT_L(0); PG8_BAR; PG8_MMA(1, 0, At, B0); PG8_MMA(1, 1, At, B1); PG8_BAR; PG8_SCHED;
            PG8_LDB(B0, 1, 0); PG8_LDB(B1, 1, 1); PG8_SCHED; PG8_LDA(At, 1, 0); PG8_STAGE(PG8_SA(0, 1), a2 + hstep, voffA);
            PG8_WAIT_V(8); PG8_WAIT_L(0); PG8_BAR; PG8_MMA(0, 0, At, B0); PG8_MMA(0, 1, At, B1); PG8_BAR; PG8_SCHED;
            PG8_LDA(At, 1, 1); PG8_STAGE(PG8_SB(1, 0), b3, voffB); PG8_STAGE(PG8_SB(1, 1), b3 + hstep, voffB); PG8_STAGE(PG8_SA(1, 0), a3, voffA);
            PG8_WAIT_V(8); PG8_WAIT_L(0); PG8_BAR; PG8_MMA(1, 0, At, B0); PG8_MMA(1, 1, At, B1); PG8_BAR; PG8_SCHED;
            } else {
            PG8_LDB(B0, 0, 0); PG8_SCHED; PG8_LDA(At, 0, 0); PG8_STAGE(PG8_SA(1, 1), a1 + hstep, voffA);
            PG8_WAIT_L(8); PG8_BAR; PG8_WAIT_L(0); PG8_MMA(0, 0, At, B0); PG8_BAR; PG8_SCHED;
            PG8_LDB(B1, 0, 1); PG8_STAGE(PG8_SB(0, 0), b2, voffB);
            PG8_BAR; PG8_WAIT_L(0); PG8_MMA(0, 1, At, B1); PG8_BAR;
            PG8_LDA(At, 0, 1); PG8_STAGE(PG8_SA(0, 0), a2, voffA);
            PG8_BAR; PG8_WAIT_L(0); PG8_MMA(1, 0, At, B0); PG8_BAR; PG8_SCHED;
            PG8_STAGE(PG8_SB(0, 1), b2 + hstep, voffB);
            PG8_WAIT_V(6); PG8_BAR; PG8_MMA(1, 1, At, B1); PG8_BAR;
            PG8_LDB(B0, 1, 0); PG8_SCHED; PG8_LDA(At, 1, 0); PG8_STAGE(PG8_SA(0, 1), a2 + hstep, voffA);
            PG8_WAIT_L(8); PG8_BAR; PG8_WAIT_L(0); PG8_MMA(0, 0, At, B0); PG8_BAR; PG8_SCHED;
            PG8_LDB(B1, 1, 1); PG8_STAGE(PG8_SB(1, 0), b3, voffB);
            PG8_BAR; PG8_WAIT_L(0); PG8_MMA(0, 1, At, B1); PG8_BAR;
            PG8_LDA(At, 1, 1); PG8_STAGE(PG8_SA(1, 0), a3, voffA);
            PG8_BAR; PG8_WAIT_L(0); PG8_MMA(1, 0, At, B0); PG8_BAR; PG8_SCHED;
            PG8_STAGE(PG8_SB(1, 1), b3 + hstep, voffB);
            PG8_WAIT_V(6); PG8_BAR; PG8_MMA(1, 1, At, B1); PG8_BAR;
            }
        }
        if constexpr (ALIGN_EPI) { if (wr == 0) PG8_BAR; }
        if constexpr (!Epi::AFTER_DRAIN) { E(acc, cur, wr, wc, fr, fq); S.done(cur); }
        if (!has_next) break;
#pragma unroll
        for (int a = 0; a < 2; ++a)
#pragma unroll
            for (int b = 0; b < 2; ++b)
#pragma unroll
                for (int m = 0; m < 4; ++m)
#pragma unroll
                    for (int n = 0; n < 2; ++n) acc[a][b][m][n] = (f32x4){0.f, 0.f, 0.f, 0.f};
        cur = nxt; cA = nA; cB = nB; ++ui;
        if constexpr (ALIGN_EPI) { if (wr == 1) PG8_BAR; }
    }
    PG8_WAIT_V(0);
    if constexpr (!ALIGN_EPI) { if (wr == 0) PG8_BAR; }
    PG8_BAR;
    if constexpr (Epi::AFTER_DRAIN) { E.fused(acc, cur, wr, wc, fr, fq, lds, wid, lane); S.done(cur); }
#undef PG8_SA
#undef PG8_SB
#undef PG8_STAGE
#undef PG8_LDA
#undef PG8_LDB
#undef PG8_MMA
#undef PG8_WAIT_V
#undef PG8_WAIT_L
#undef PG8_BAR
#undef PG8_SCHED
}
}

#define GAS __attribute__((address_space(1)))
#define LAS __attribute__((address_space(3)))
typedef unsigned short bf16;
typedef float f32x4 __attribute__((ext_vector_type(4)));
typedef float f32x16 __attribute__((ext_vector_type(16)));
typedef short bf16x8 __attribute__((ext_vector_type(8)));
typedef short s16x4 __attribute__((ext_vector_type(4)));
typedef unsigned u32x4 __attribute__((ext_vector_type(4)));
typedef unsigned u32x2 __attribute__((ext_vector_type(2)));

constexpr int DM = 1024, NB = 8, SEQ = 2048, DEPTH = 2, DB = 32, DS = 4, PAST = 8192;
constexpr int MP = NB * SEQ, MS = DB * DS, MR = MP + MS, MPAD = 16640;
constexpr int DFF = 2816, NGU = 2 * DFF, NIN = 5376, NAS = 768;
constexpr int C_Q = 0, C_K = 768, C_V = 1536, C_U = 2304, C_VS = 2816, C_GA = 3328, C_GB = 4352;
constexpr float EPS = 1e-6f;
constexpr float LOG2E = 1.4426950408889634f;
constexpr float QSCALE = 0.125f * LOG2E;
constexpr int NWAVES = 8, NTHR = 512;
constexpr int LDS_BYTES = 147456;

constexpr size_t O_YP = 0, O_YS = 16777216, O_KP0 = 16908288, O_KP1 = 17956864, O_KP2 = 22151168,
                 O_KS0 = 38928384, O_KS1 = 39059456, O_KS2 = 39190528, O_GV = 39321600, O_TOTAL = 39452672;

constexpr size_t MiB = 1u << 20;
constexpr size_t WS_SS = 0;
constexpr size_t WS_W = 1 * MiB;
constexpr size_t WL_GU1 = 0, WL_DN1 = WL_GU1 + (size_t)NGU * DM * 2, WL_IN = WL_DN1 + (size_t)DM * DFF * 2, WL_PA = WL_IN + (size_t)NIN * DM * 2,
                 WL_PS = WL_PA + (size_t)DM * 256 * 2, WL_WO = WL_PS + (size_t)DM * 512 * 2, WL_GU2 = WL_WO + (size_t)DM * DM * 2,
                 WL_DN2 = WL_GU2 + (size_t)NGU * DM * 2, WL_TRIL = WL_DN2 + (size_t)DM * DFF * 2, WL_END = WL_TRIL + 4 * 128 * 128 * 2;
constexpr size_t WL_STRIDE = 48 * MiB;
static_assert(WL_END <= WL_STRIDE, "weights per layer");
constexpr size_t WS_X = WS_W + 2 * WL_STRIDE;
constexpr size_t WS_XB = WS_X + (size_t)MPAD * DM * 4;
constexpr size_t WS_Z = WS_XB + (size_t)MPAD * DM * 2;
constexpr size_t WS_ATT = WS_Z + (size_t)MPAD * NIN * 2;
constexpr size_t WS_SP = WS_ATT + (size_t)MPAD * 256 * 2;
constexpr size_t WS_MIX = WS_SP + (size_t)MPAD * 512 * 2;
constexpr size_t WS_KC = WS_MIX + (size_t)MPAD * DM * 2;
constexpr size_t WS_VC = WS_KC + (size_t)NB * 12 * SEQ * 64 * 2;
constexpr size_t WS_END = WS_VC + (size_t)NB * 12 * SEQ * 64 * 2;

struct Args { const float* in[22]; float* out; unsigned char* ws; int ph_lo, ph_hi; };

__device__ __forceinline__ unsigned f2bf(float f) { unsigned u = __builtin_bit_cast(unsigned, f); return (u + 0x7fffu + ((u >> 16) & 1u)) >> 16; }
__device__ __forceinline__ unsigned pk2(float lo, float hi) { return pg8::cvt_pk_bf16(lo, hi); }
__device__ __forceinline__ float bflo(unsigned w) { return __builtin_bit_cast(float, w << 16); }
__device__ __forceinline__ float bfhi(unsigned w) { return __builtin_bit_cast(float, w & 0xffff0000u); }
__device__ __forceinline__ float fexp2(float x) { return __builtin_amdgcn_exp2f(x); }
__device__ __forceinline__ float frcp(float x) { return __builtin_amdgcn_rcpf(x); }
__device__ __forceinline__ float sigmoidf_(float x) { return frcp(1.0f + fexp2(-LOG2E * x)); }
__device__ __forceinline__ float gelu_tanh(float x) {
    const float t = x * (1.0f + 0.044715f * x * x) * (2.0f * 0.7978845608028654f);
    return x * frcp(1.0f + fexp2(-LOG2E * t));
}
__device__ __forceinline__ float wave_sum(float v) {
#pragma unroll
    for (int o = 1; o < 64; o <<= 1) v += __shfl_xor(v, o);
    return v;
}
__device__ __forceinline__ float wave_max(float v) {
#pragma unroll
    for (int o = 1; o < 64; o <<= 1) v = fmaxf(v, __shfl_xor(v, o));
    return v;
}

#define XB_TMO      128
#define XB_XCNT(j)  (256  + 64 * (j))
#define XB_XSUB(j)  (1280 + 64 * (j))
#define XB_XGEN(j)  (2304 + 64 * (j))
#define XB_TOP      3328
#define XB_TOPGEN   3392
#define XCD_BAR_WORDS 3456
#define XB_SPIN_CAP (1u << 18)

__device__ __forceinline__ unsigned xb_ld(unsigned* p)              { return __hip_atomic_load(p, __ATOMIC_RELAXED, __HIP_MEMORY_SCOPE_AGENT); }
__device__ __forceinline__ unsigned xb_add(unsigned* p, unsigned v) { return __hip_atomic_fetch_add(p, v, __ATOMIC_RELAXED, __HIP_MEMORY_SCOPE_AGENT); }
__device__ __forceinline__ unsigned xb_xcc_id() { return (unsigned)__builtin_amdgcn_s_getreg((3 << 11) | 20) & 0xFu; }
#define XB_SPIN(cond, bar) do { unsigned _sp = 0; while (cond) { __builtin_amdgcn_s_sleep(1); \
    if ((++_sp & 255u) == 0u) { if (xb_ld(&(bar)[XB_TMO])) break; if (_sp > XB_SPIN_CAP) { atomicAdd(&(bar)[XB_TMO], 1u); break; } } } } while (0)

struct XcdBarrier {
    unsigned* bar; unsigned x;
    volatile LAS unsigned* st;
};

__device__ __forceinline__ XcdBarrier xcd_barrier_post(unsigned* bar, volatile LAS unsigned* st) {
    XcdBarrier b; b.bar = bar; b.x = xb_xcc_id(); b.st = st;
    if (threadIdx.x == 0) (void)xb_add(&bar[XB_XCNT(b.x)], 1u);
    return b;
}
__device__ __forceinline__ void xcd_barrier_complete(unsigned* bar, unsigned x, unsigned& nloc, unsigned& nx) {
    const unsigned G = gridDim.x * gridDim.y * gridDim.z;
    unsigned sum, cnt, mine, sp = 0u;
    for (;;) {
        sum = 0u; cnt = 0u; mine = 0u;
#pragma unroll
        for (unsigned j = 0; j < 16; ++j) { const unsigned c = xb_ld(&bar[XB_XCNT(j)]); sum += c; cnt += (c > 0u) ? 1u : 0u; mine = (j == x) ? c : mine; }
        if (sum == G) break;
        __builtin_amdgcn_s_sleep(1);
        if ((++sp & 255u) == 0u) { if (xb_ld(&bar[XB_TMO])) break; if (sp > XB_SPIN_CAP) { atomicAdd(&bar[XB_TMO], 1u); break; } }
    }
    nloc = mine > 0u ? mine : 1u; nx = cnt > 0u ? cnt : 1u;
}

__device__ __forceinline__ void xcd_barrier(const XcdBarrier& b) {
    asm volatile("s_waitcnt vmcnt(0)" ::: "memory");
    __syncthreads();
    if (threadIdx.x == 0) {
        unsigned* bar = b.bar;
        __builtin_amdgcn_s_waitcnt(0);
        unsigned nloc = b.st[0], nx = b.st[1];
        if (nloc == 0u) { xcd_barrier_complete(bar, b.x, nloc, nx); b.st[0] = nloc; b.st[1] = nx; }
        const unsigned old = xb_add(&bar[XB_XSUB(b.x)], 1u);
        const unsigned gen = old / nloc;
        if (old + 1u == (gen + 1u) * nloc) {
            __builtin_amdgcn_fence(__ATOMIC_RELEASE, "agent");
            asm volatile("s_waitcnt vmcnt(0)" ::: "memory");
            const unsigned og = xb_add(&bar[XB_TOP], 1u);
            const unsigned tg = og / nx;
            if (og + 1u == (tg + 1u) * nx) xb_add(&bar[XB_TOPGEN], 1u);
            else XB_SPIN(xb_ld(&bar[XB_TOPGEN]) == tg, bar);
            __builtin_amdgcn_fence(__ATOMIC_ACQUIRE, "agent");
            xb_add(&bar[XB_XGEN(b.x)], 1u);
            asm volatile("s_waitcnt vmcnt(0)" ::: "memory");
        } else {
            XB_SPIN(xb_ld(&bar[XB_XGEN(b.x)]) == gen, bar);
            __builtin_amdgcn_fence(__ATOMIC_ACQUIRE, "agent");
            asm volatile("s_waitcnt vmcnt(0)" ::: "memory");
        }
    }
    __syncthreads();
}

constexpr size_t WS_CTL0 = 640 * 1024, WS_CTL_BYTES = 256 * 1024;
constexpr size_t WS_PCNT = 640 * 1024;
constexpr size_t WS_BAR = 768 * 1024;
constexpr int LDS_MISC = 147456 - 64;

struct EpiGU {
    static constexpr bool PERM = true, AFTER_DRAIN = false;
    bf16* H; const float* ss;
    __device__ __forceinline__ void operator()(const f32x4 (&acc)[2][2][4][2], const pg8::Unit& u, int wr, int wc, int fr, int fq) const {
        const int row0 = u.pm * 256 + wr * 64 + fr, col0 = u.pn * 128 + wc * 32 + 8 * fq;
#pragma unroll
        for (int ai = 0; ai < 2; ++ai)
#pragma unroll
            for (int m = 0; m < 4; ++m) {
                const int row = row0 + ai * 128 + m * 16;
                const float r = rsqrtf(ss[row] * (1.0f / DM) + EPS);
                unsigned w[4];
#pragma unroll
                for (int n = 0; n < 2; ++n) {
                    float hv[4];
#pragma unroll
                    for (int e = 0; e < 4; ++e) { const float g = acc[ai][0][m][n][e] * r, up = acc[ai][1][m][n][e] * r; hv[e] = g * sigmoidf_(g) * up; }
                    w[2 * n] = pk2(hv[0], hv[1]); w[2 * n + 1] = pk2(hv[2], hv[3]);
                }
                *(u32x4*)(H + (size_t)row * DFF + col0) = (u32x4){w[0], w[1], w[2], w[3]};
            }
    }
};
template <bool F32IN> struct EpiResT {
    static constexpr bool PERM = true, AFTER_DRAIN = false;
    const float* Xin; bf16* XB; float* ssn; float alpha;
    __device__ __forceinline__ void operator()(const f32x4 (&acc)[2][2][4][2], const pg8::Unit& u, int wr, int wc, int fr, int fq) const {
        const int row0 = u.pm * 256 + wr * 64 + fr, col0 = u.pn * 256 + wc * 32 + 8 * fq;
        if constexpr (!F32IN) {
            u32x4 xw[2][4][2];
#pragma unroll
            for (int ai = 0; ai < 2; ++ai)
#pragma unroll
                for (int m = 0; m < 4; ++m)
#pragma unroll
                    for (int bj = 0; bj < 2; ++bj) xw[ai][m][bj] = *(const u32x4*)(XB + (size_t)(row0 + ai * 128 + m * 16) * DM + col0 + bj * 128);
            float sq[2][4];
#pragma unroll
            for (int ai = 0; ai < 2; ++ai)
#pragma unroll
                for (int m = 0; m < 4; ++m) {
                    const int row = row0 + ai * 128 + m * 16;
                    float s = 0.f;
#pragma unroll
                    for (int bj = 0; bj < 2; ++bj) {
                        const u32x4 w = xw[ai][m][bj];
                        const f32x4 x0 = (f32x4){bflo(w.x), bfhi(w.x), bflo(w.y), bfhi(w.y)} + acc[ai][bj][m][0] * alpha, x1 = (f32x4){bflo(w.z), bfhi(w.z), bflo(w.w), bfhi(w.w)} + acc[ai][bj][m][1] * alpha;
                        *(u32x4*)(XB + (size_t)row * DM + col0 + bj * 128) = (u32x4){pk2(x0[0], x0[1]), pk2(x0[2], x0[3]), pk2(x1[0], x1[1]), pk2(x1[2], x1[3])};
                        s += ((x0[0] * x0[0] + x0[1] * x0[1]) + (x0[2] * x0[2] + x0[3] * x0[3])) + ((x1[0] * x1[0] + x1[1] * x1[1]) + (x1[2] * x1[2] + x1[3] * x1[3]));
                    }
                    s += __shfl_xor(s, 16); s += __shfl_xor(s, 32);
                    sq[ai][m] = s;
                }
#pragma unroll
            for (int ai = 0; ai < 2; ++ai) {
                const float v = fq == 0 ? sq[ai][0] : fq == 1 ? sq[ai][1] : fq == 2 ? sq[ai][2] : sq[ai][3];
                unsafeAtomicAdd(ssn + row0 + ai * 128 + fq * 16, v);
            }
        } else {
#pragma unroll
        for (int ai = 0; ai < 2; ++ai) {
            f32x4 xin[4][2][2];
#pragma unroll
            for (int m = 0; m < 4; ++m)
#pragma unroll
                for (int bj = 0; bj < 2; ++bj) {
                    const size_t off = (size_t)(row0 + ai * 128 + m * 16) * DM + col0 + bj * 128;
                    xin[m][bj][0] = *(const f32x4*)(Xin + off); xin[m][bj][1] = *(const f32x4*)(Xin + off + 4);
                }
#pragma unroll
            for (int m = 0; m < 4; ++m) {
                const int row = row0 + ai * 128 + m * 16;
                float s = 0.f;
#pragma unroll
                for (int bj = 0; bj < 2; ++bj) {
                    const size_t off = (size_t)row * DM + col0 + bj * 128;
                    const f32x4 x0 = xin[m][bj][0] + acc[ai][bj][m][0] * alpha, x1 = xin[m][bj][1] + acc[ai][bj][m][1] * alpha;
                    *(u32x4*)(XB + off) = (u32x4){pk2(x0[0], x0[1]), pk2(x0[2], x0[3]), pk2(x1[0], x1[1]), pk2(x1[2], x1[3])};
                    s += ((x0[0] * x0[0] + x0[1] * x0[1]) + (x0[2] * x0[2] + x0[3] * x0[3])) + ((x1[0] * x1[0] + x1[1] * x1[1]) + (x1[2] * x1[2] + x1[3] * x1[3]));
                }
                s += __shfl_xor(s, 16); s += __shfl_xor(s, 32);
                if (fq == 0) unsafeAtomicAdd(ssn + row, s);
            }
        }
        }
    }
};
struct EpiResFinal {
    static constexpr bool PERM = true, AFTER_DRAIN = false;
    const bf16* Xin; float* Y; float* ssn; unsigned* pcnt; const float* gain; float alpha;
    __device__ __forceinline__ void operator()(const f32x4 (&acc)[2][2][4][2], const pg8::Unit& u, int wr, int wc, int fr, int fq) const {
        const int row0 = u.pm * 256 + wr * 64 + fr, col0 = u.pn * 256 + wc * 32 + 8 * fq;
#pragma unroll
        for (int ai = 0; ai < 2; ++ai) {
            u32x4 xw[4][2];
#pragma unroll
            for (int m = 0; m < 4; ++m)
#pragma unroll
                for (int bj = 0; bj < 2; ++bj) xw[m][bj] = *(const u32x4*)(Xin + (size_t)(row0 + ai * 128 + m * 16) * DM + col0 + bj * 128);
#pragma unroll
            for (int m = 0; m < 4; ++m) {
                float s = 0.f;
#pragma unroll
                for (int bj = 0; bj < 2; ++bj) {
                    const u32x4 w = xw[m][bj];
                    const f32x4 x0 = (f32x4){bflo(w.x), bfhi(w.x), bflo(w.y), bfhi(w.y)} + acc[ai][bj][m][0] * alpha, x1 = (f32x4){bflo(w.z), bfhi(w.z), bflo(w.w), bfhi(w.w)} + acc[ai][bj][m][1] * alpha;
                    s += ((x0[0] * x0[0] + x0[1] * x0[1]) + (x0[2] * x0[2] + x0[3] * x0[3])) + ((x1[0] * x1[0] + x1[1] * x1[1]) + (x1[2] * x1[2] + x1[3] * x1[3]));
                }
                s += __shfl_xor(s, 16); s += __shfl_xor(s, 32);
                if (fq == 0) unsafeAtomicAdd(ssn + row0 + ai * 128 + m * 16, s);
            }
        }
        asm volatile("s_waitcnt vmcnt(0)" ::: "memory");
        unsigned* cnt = pcnt + 64 * u.pm;
        if ((threadIdx.x & 63) == 0) __hip_atomic_fetch_add(cnt, 1u, __ATOMIC_RELAXED, __HIP_MEMORY_SCOPE_AGENT);
        { unsigned sp = 0; while ((unsigned)__builtin_amdgcn_readfirstlane(__hip_atomic_load(cnt, __ATOMIC_RELAXED, __HIP_MEMORY_SCOPE_AGENT)) < 32u && ++sp < (1u << 20)) __builtin_amdgcn_s_sleep(2); }
        asm volatile("" ::: "memory");
        f32x4 gv[2][2];
#pragma unroll
        for (int bj = 0; bj < 2; ++bj)
#pragma unroll
            for (int n = 0; n < 2; ++n) gv[bj][n] = *(const f32x4*)(gain + col0 + bj * 128 + 4 * n);
#pragma unroll
        for (int ai = 0; ai < 2; ++ai) {
            u32x4 xw[4][2]; float rr[4];
#pragma unroll
            for (int m = 0; m < 4; ++m) {
                const int row = row0 + ai * 128 + m * 16;
                rr[m] = rsqrtf(__hip_atomic_load(ssn + row, __ATOMIC_RELAXED, __HIP_MEMORY_SCOPE_AGENT) * (1.0f / DM) + EPS);
#pragma unroll
                for (int bj = 0; bj < 2; ++bj) xw[m][bj] = *(const u32x4*)(Xin + (size_t)row * DM + col0 + bj * 128);
            }
#pragma unroll
            for (int m = 0; m < 4; ++m)
#pragma unroll
                for (int bj = 0; bj < 2; ++bj) {
                    const int row = row0 + ai * 128 + m * 16;
                    const u32x4 w = xw[m][bj];
                    const f32x4 x0 = (f32x4){bflo(w.x), bfhi(w.x), bflo(w.y), bfhi(w.y)} + acc[ai][bj][m][0] * alpha, x1 = (f32x4){bflo(w.z), bfhi(w.z), bflo(w.w), bfhi(w.w)} + acc[ai][bj][m][1] * alpha;
                    float* yp = Y + (size_t)row * DM + col0 + bj * 128;
                    *(f32x4*)yp = x0 * rr[m] * gv[bj][0]; *(f32x4*)(yp + 4) = x1 * rr[m] * gv[bj][1];
                }
        }
    }
};
struct EpiIn {
    static constexpr bool PERM = true, AFTER_DRAIN = false;
    bf16* Z; const float* ss; float* ssv; float* out; int layer; bf16* KC; bf16* VC;
    __device__ __forceinline__ void operator()(const f32x4 (&acc)[2][2][4][2], const pg8::Unit& u, int wr, int wc, int fr, int fq) const {
        const int pn = u.pn;
        const int row0 = u.pm * 256 + wr * 64 + fr, cc0 = wc * 32 + 8 * fq;
        const int type = pn < 3 ? 0 : pn < 9 ? 1 : pn < 11 ? 2 : pn < 13 ? 3 : 4;
        const int g = (pn - 3) % 3, kvsel = (pn - 3) / 3;
        const int keep = 128 << (2 * g);
        const size_t okp = g == 0 ? O_KP0 : g == 1 ? O_KP1 : O_KP2;
        const size_t oks = g == 0 ? O_KS0 : g == 1 ? O_KS1 : O_KS2;
        float rr[2][4];
#pragma unroll
        for (int ai = 0; ai < 2; ++ai)
#pragma unroll
            for (int m = 0; m < 4; ++m) rr[ai][m] = ss[row0 + ai * 128 + m * 16];
#pragma unroll
        for (int ai = 0; ai < 2; ++ai)
#pragma unroll
            for (int m = 0; m < 4; ++m) {
                const int row = row0 + ai * 128 + m * 16;
                const float r = rsqrtf(rr[ai][m] * (1.0f / DM) + EPS);
                float sv = 0.f;
#pragma unroll
                for (int bj = 0; bj < 2; ++bj) {
                    f32x4 v0 = acc[ai][bj][m][0] * r, v1 = acc[ai][bj][m][1] * r;
                    const int cc = bj * 128 + cc0;
                    if (type == 0) { v0 = v0 * QSCALE; v1 = v1 * QSCALE; }
                    else if (type == 1) {
                        if (row < MP) {
                            const int b = row >> 11, t = row & 2047, trow = t - (SEQ - keep);
                            if (trow >= 0) { float* o = out + okp + ((size_t)((layer * NB + b) * keep + trow) * 2 + kvsel) * 256 + cc; *(f32x4*)o = v0; *(f32x4*)(o + 4) = v1; }
                        } else if (row < MR) {
                            float* o = out + oks + ((size_t)(layer * MS + (row - MP)) * 2 + kvsel) * 256 + cc; *(f32x4*)o = v0; *(f32x4*)(o + 4) = v1;
                        }
                    } else if (type == 2 || type == 3) {
#pragma unroll
                        for (int e = 0; e < 4; ++e) { v0[e] = gelu_tanh(v0[e]); v1[e] = gelu_tanh(v1[e]); }
                        if (type == 3) sv += (v0[0] * v0[0] + v0[1] * v0[1]) + (v0[2] * v0[2] + v0[3] * v0[3]) + (v1[0] * v1[0] + v1[1] * v1[1]) + (v1[2] * v1[2] + v1[3] * v1[3]);
                    } else {
#pragma unroll
                        for (int e = 0; e < 4; ++e) { v0[e] = sigmoidf_(v0[e]); v1[e] = sigmoidf_(v1[e]); }
                    }
                    const u32x4 pk = (u32x4){pk2(v0[0], v0[1]), pk2(v0[2], v0[3]), pk2(v1[0], v1[1]), pk2(v1[2], v1[3])};
                    if (type == 1 && row < MP) {
                        const int b = row >> 11, t = row & 2047, posp = (t & ((1 << (2 * g)) - 1)) * (SEQ >> (2 * g)) + (t >> (2 * g));
                        *(u32x4*)((kvsel ? VC : KC) + ((size_t)((b * 3 + g) * 4 + (cc >> 6)) * SEQ + posp) * 64 + (cc & 63)) = pk;
                    } else *(u32x4*)(Z + (size_t)row * NIN + pn * 256 + cc) = pk;
                }
                if (type == 3) { sv += __shfl_xor(sv, 16); sv += __shfl_xor(sv, 32); if (fq == 0) unsafeAtomicAdd(ssv + row, sv); }
            }
    }
};
template <int PASS> struct EpiProj {
    static constexpr bool PERM = true, AFTER_DRAIN = false;
    bf16* MIX; const bf16* Z;
    __device__ __forceinline__ void operator()(const f32x4 (&acc)[2][2][4][2], const pg8::Unit& u, int wr, int wc, int fr, int fq) const {
        const int row0 = u.pm * 256 + wr * 64 + fr, col0 = u.pn * 256 + wc * 32 + 8 * fq;
        u32x4 gall[2][4][2];
        if (PASS == 0) {
#pragma unroll
            for (int ai = 0; ai < 2; ++ai)
#pragma unroll
                for (int m = 0; m < 4; ++m)
#pragma unroll
                    for (int bj = 0; bj < 2; ++bj) gall[ai][m][bj] = *(const u32x4*)(Z + (size_t)(row0 + ai * 128 + m * 16) * NIN + C_GA + col0 + bj * 128);
        }
#pragma unroll
        for (int ai = 0; ai < 2; ++ai) {
            u32x4 gw[4][2], pw[4][2];
#pragma unroll
            for (int m = 0; m < 4; ++m)
#pragma unroll
                for (int bj = 0; bj < 2; ++bj) {
                    const size_t row = (size_t)(row0 + ai * 128 + m * 16);
                    if (PASS == 0) gw[m][bj] = gall[ai][m][bj];
                    else { gw[m][bj] = *(const u32x4*)(Z + row * NIN + C_GB + col0 + bj * 128); pw[m][bj] = *(const u32x4*)(MIX + row * DM + col0 + bj * 128); }
                }
#pragma unroll
            for (int m = 0; m < 4; ++m)
#pragma unroll
                for (int bj = 0; bj < 2; ++bj) {
                    const size_t row = (size_t)(row0 + ai * 128 + m * 16);
                    const u32x4 g = gw[m][bj];
                    const f32x4 a0 = acc[ai][bj][m][0], a1 = acc[ai][bj][m][1];
                    float o[8];
                    o[0] = bflo(g[0]) * a0[0]; o[1] = bfhi(g[0]) * a0[1]; o[2] = bflo(g[1]) * a0[2]; o[3] = bfhi(g[1]) * a0[3];
                    o[4] = bflo(g[2]) * a1[0]; o[5] = bfhi(g[2]) * a1[1]; o[6] = bflo(g[3]) * a1[2]; o[7] = bfhi(g[3]) * a1[3];
                    if (PASS == 1) {
                        const u32x4 p = pw[m][bj];
                        o[0] += bflo(p[0]); o[1] += bfhi(p[0]); o[2] += bflo(p[1]); o[3] += bfhi(p[1]);
                        o[4] += bflo(p[2]); o[5] += bfhi(p[2]); o[6] += bflo(p[3]); o[7] += bfhi(p[3]);
                    }
                    *(u32x4*)(MIX + row * DM + col0 + bj * 128) = (u32x4){pk2(o[0], o[1]), pk2(o[2], o[3]), pk2(o[4], o[5]), pk2(o[6], o[7])};
                }
            asm volatile("" ::: "memory");
        }
    }
};

__device__ __forceinline__ void transpose_item(const float* W, int K, int N, bf16* WT, int k0, int n0, int dst_row0, const float* gain, LAS float* scr, int lane) {
    f32x4 v[16];
    const int lr = lane >> 4, lc = (lane & 15) * 4;
    const float* src = W + (size_t)(k0 + lr) * N + n0 + lc;
#pragma unroll
    for (int i = 0; i < 16; ++i) v[i] = *(const f32x4*)(src + (size_t)(4 * i) * N);
    const int c = lane & 7;
    f32x4 g0 = (f32x4){1.f, 1.f, 1.f, 1.f}, g1 = g0;
    if (gain) { g0 = *(const f32x4*)(gain + k0 + 8 * c); g1 = *(const f32x4*)(gain + k0 + 8 * c + 4); }
#pragma unroll
    for (int i = 0; i < 16; ++i) { LAS float* d = scr + (4 * i + lr) * 65 + lc; d[0] = v[i][0]; d[1] = v[i][1]; d[2] = v[i][2]; d[3] = v[i][3]; }
    asm volatile("s_waitcnt lgkmcnt(0)" ::: "memory");
#pragma unroll
    for (int j = 0; j < 8; ++j) { const int n = (lane >> 3) + 8 * j; const LAS float* sp = scr + (8 * c) * 65 + n;
        u32x4 o; o.x = pk2(sp[0 * 65] * g0[0], sp[1 * 65] * g0[1]); o.y = pk2(sp[2 * 65] * g0[2], sp[3 * 65] * g0[3]); o.z = pk2(sp[4 * 65] * g1[0], sp[5 * 65] * g1[1]); o.w = pk2(sp[6 * 65] * g1[2], sp[7 * 65] * g1[3]);
        *(u32x4*)(WT + (size_t)(dst_row0 + n) * K + k0 + 8 * c) = o; }
    asm volatile("s_waitcnt lgkmcnt(0)" ::: "memory");
}
__device__ __forceinline__ void conv_matrix_item(const float* W, int K, int N, bf16* WT, int item, int mode  , const float* gain, LAS float* scr, int lane) {
    const int nblk = N / 64, kb = item / nblk, nb = item % nblk, n0 = 64 * nb;
    const int dst = mode == 0 ? n0 : ((n0 >> 7) * 256 + (n0 & 127) + (mode == 2 ? 128 : 0));
    transpose_item(W, K, N, WT, 64 * kb, n0, dst, gain, scr, lane);
}

constexpr int I_G = (DM / 64) * (DFF / 64), I_D = (DFF / 64) * (DM / 64), I_IN = (DM / 64) * (NIN / 64), I_PA = (256 / 64) * (DM / 64), I_PS = (512 / 64) * (DM / 64), I_WO = (DM / 64) * (DM / 64);
constexpr int I_LAYER = 6 * I_G + I_IN + I_PA + I_PS + I_WO;
constexpr int I_FFN1 = 3 * I_G, I_MIXW = I_IN + I_PA + I_PS + I_WO, I_FFN2_0 = I_FFN1 + I_MIXW;
static_assert(I_G == I_D, "items");
__device__ __forceinline__ void conv_layer_item(const Args& a, int l, int r, LAS float* scr, int lane) {
    unsigned char* wl = a.ws + WS_W + (size_t)l * WL_STRIDE;
    if (r < I_G) { conv_matrix_item(a.in[6] + (size_t)l * DM * DFF, DM, DFF, (bf16*)(wl + WL_GU1), r, 1, a.in[5] + l * DM, scr, lane); return; } r -= I_G;
    if (r < I_G) { conv_matrix_item(a.in[7] + (size_t)l * DM * DFF, DM, DFF, (bf16*)(wl + WL_GU1), r, 2, a.in[5] + l * DM, scr, lane); return; } r -= I_G;
    if (r < I_D) { conv_matrix_item(a.in[8] + (size_t)l * DFF * DM, DFF, DM, (bf16*)(wl + WL_DN1), r, 0, nullptr, scr, lane); return; } r -= I_D;
    if (r < I_IN) { conv_matrix_item(a.in[10] + (size_t)l * DM * NIN, DM, NIN, (bf16*)(wl + WL_IN), r, 0, a.in[9] + l * DM, scr, lane); return; } r -= I_IN;
    if (r < I_PA) { conv_matrix_item(a.in[14] + (size_t)l * 256 * DM, 256, DM, (bf16*)(wl + WL_PA), r, 0, nullptr, scr, lane); return; } r -= I_PA;
    if (r < I_PS) { conv_matrix_item(a.in[15] + (size_t)l * 512 * DM, 512, DM, (bf16*)(wl + WL_PS), r, 0, nullptr, scr, lane); return; } r -= I_PS;
    if (r < I_WO) { conv_matrix_item(a.in[16] + (size_t)l * DM * DM, DM, DM, (bf16*)(wl + WL_WO), r, 0, nullptr, scr, lane); return; } r -= I_WO;
    if (r < I_G) { conv_matrix_item(a.in[18] + (size_t)l * DM * DFF, DM, DFF, (bf16*)(wl + WL_GU2), r, 1, a.in[17] + l * DM, scr, lane); return; } r -= I_G;
    if (r < I_G) { conv_matrix_item(a.in[19] + (size_t)l * DM * DFF, DM, DFF, (bf16*)(wl + WL_GU2), r, 2, a.in[17] + l * DM, scr, lane); return; } r -= I_G;
    conv_matrix_item(a.in[20] + (size_t)l * DFF * DM, DFF, DM, (bf16*)(wl + WL_DN2), r, 0, nullptr, scr, lane);
}
__device__ __forceinline__ void conv_items(const Args& a, LAS unsigned char* lds, int lo, int hi, int widx, int nw, int wave, int lane) {
    LAS float* scr = (LAS float*)(lds + wave * 16640);
    for (int it = hi - 1 - widx; it >= lo; it -= nw) conv_layer_item(a, it / I_LAYER, it % I_LAYER, scr, lane);
}
__device__ __forceinline__ void conv_in_idle_tail(const Args& a, LAS unsigned char* lds, int nwg_tiles, int lo, int hi, int wave, int lane) {
    const int G = gridDim.x, wg = blockIdx.x;
    const int first_idle = nwg_tiles % G;
    if (wg < first_idle) return;
    conv_items(a, lds, lo, hi, (wg - first_idle) * NWAVES + wave, (G - first_idle) * NWAVES, wave, lane);
}

__device__ __forceinline__ void phase_prologue(const Args& a, LAS unsigned char* lds, int gw, int NGW, int lane, int wave) {
    unsigned char* ws = a.ws;
    { float* ss = (float*)(ws + WS_SS); const int gt = gw * 64 + lane, NT = NGW * 64;
      for (int i = MPAD + gt; i < 9 * MPAD; i += NT) ss[i] = 0.f; }
    conv_items(a, lds, 0, 2 * I_LAYER, gw, NGW, wave, lane);
    { const int gt = gw * 64 + lane, NT = NGW * 64;
      for (int i = gt; i < 2 * 4 * 128 * 128; i += NT) { const int l = i >> 16, rem = i & 65535, t = (rem >> 7) & 127, s = rem & 127;
          const float v = s <= t ? a.in[12][i] : 0.f; ((bf16*)(ws + WS_W + (size_t)l * WL_STRIDE + WL_TRIL))[rem] = (bf16)f2bf(v); } }
    bf16* XB = (bf16*)(ws + WS_XB); float* ss0 = (float*)(ws + WS_SS);
    for (int m = gw; m < MPAD; m += NGW) {
        f32x4 v[4]; float s = 0.f;
        if (m < MR) { const float* src = m < MP ? a.in[0] + (size_t)m * DM : a.in[1] + (size_t)(m - MP) * DM;
#pragma unroll
            for (int j = 0; j < 4; ++j) { v[j] = *(const f32x4*)(src + 4 * lane + 256 * j); s += (v[j][0] * v[j][0] + v[j][1] * v[j][1]) + (v[j][2] * v[j][2] + v[j][3] * v[j][3]); }
        } else {
#pragma unroll
            for (int j = 0; j < 4; ++j) v[j] = (f32x4){0.f, 0.f, 0.f, 0.f};
        }
        s = wave_sum(s);
#pragma unroll
        for (int j = 0; j < 4; ++j) *(u32x2*)(XB + (size_t)m * DM + 4 * lane + 256 * j) = (u32x2){pk2(v[j][0], v[j][1]), pk2(v[j][2], v[j][3])};
        if (lane == 0) ss0[m] = s;
    }
}

#define MFMA32(a, b, c) __builtin_amdgcn_mfma_f32_32x32x16_bf16((a), (b), (c), 0, 0, 0)
typedef short v4i16_t __attribute__((ext_vector_type(4)));
__device__ __forceinline__ s16x4 tr_read(const LAS unsigned char* p) { return __builtin_bit_cast(s16x4, __builtin_amdgcn_ds_read_tr16_b64_v4i16((LAS v4i16_t*)p)); }
__device__ __forceinline__ float alibi_slope2(int hidx) { return fexp2(-8.0f * (float)(hidx + 1) / 12.0f) * LOG2E; }

constexpr int VP = 192;
constexpr int KP = 144;
constexpr int ATT_WAVE_LDS = 32 * VP + 32 * KP;

__device__ __forceinline__ void attn_prompt_task(const bf16* Z, const bf16* KC, const bf16* VC, bf16* AS, int task, LAS unsigned char* vl, int lane) {
    const int rho = task & 15, c5 = (task >> 4) & 3, islot = (task >> 6) & 3, b = task >> 8;
    const int ql = lane & 31, h = lane >> 5;
    const int t0 = 512 * c5 + rho, tq = t0 + 16 * ql, tmax = t0 + 496;
    const size_t rowq = (size_t)b * SEQ + tq;
    f32x16 o0, o1;
#pragma unroll
    for (int i = 0; i < 16; ++i) { o0[i] = 0.f; o1[i] = 0.f; }
    float mrun = -1e30f, lrun = 0.f;
    const int i16 = lane & 15, tq_ = i16 >> 2, tp = i16 & 3, blk = (lane >> 4) & 1;
    const int traddr = (4 * h + tq_) * VP + 32 * blk + 8 * tp;
    const int crow_ = lane >> 3, cchk = lane & 7;
    LAS unsigned char* kl = vl + 32 * VP;
    for (int g = 0; g < 3; ++g) {
        const int dil = 1 << (2 * g), W = 128 << (2 * g), nblk = g == 0 ? 20 : g == 1 ? 8 : 5;
        const float slope2 = alibi_slope2(g * 4 + islot);
        const int qcol = C_Q + g * 256 + islot * 64 + 8 * h;
        const int rres = tmax & (dil - 1), nper = SEQ >> (2 * g);
        const bf16* kbase = KC + ((size_t)((b * 3 + g) * 4 + islot) * SEQ + rres * nper) * 64;
        const bf16* vbase = VC + ((size_t)((b * 3 + g) * 4 + islot) * SEQ + rres * nper) * 64;
        bf16x8 qf[4];
#pragma unroll
        for (int st = 0; st < 4; ++st) qf[st] = *(const bf16x8*)(Z + rowq * NIN + qcol + 16 * st);
        const int lim = tq < W ? tq : W;
        u32x4 krn[4], vrn[4];
        {   const int jb0 = (tmax - dil * 31 - rres) >> (2 * g);
#pragma unroll
            for (int i = 0; i < 4; ++i) { int rj = jb0 + crow_ + 8 * i; rj = rj < 0 ? 0 : rj; krn[i] = *(const u32x4*)(kbase + (size_t)rj * 64 + 8 * cchk); vrn[i] = *(const u32x4*)(vbase + (size_t)rj * 64 + 8 * cchk); }
        }
        for (int c = 0; c < nblk; ++c) {
            const int kb = tmax - dil * (32 * c + 31);
            if (kb + 31 * dil < 0) break;
            u32x4 kr[4], vr[4];
#pragma unroll
            for (int i = 0; i < 4; ++i) { kr[i] = krn[i]; vr[i] = vrn[i]; }
            {
                const int jb1 = ((kb - rres) >> (2 * g)) - 32;
#pragma unroll
                for (int i = 0; i < 4; ++i) { int rj = jb1 + crow_ + 8 * i; rj = rj < 0 ? 0 : rj; krn[i] = *(const u32x4*)(kbase + (size_t)rj * 64 + 8 * cchk); vrn[i] = *(const u32x4*)(vbase + (size_t)rj * 64 + 8 * cchk); }
            }
#pragma unroll
            for (int i = 0; i < 4; ++i) { *(LAS u32x4*)(kl + (crow_ + 8 * i) * KP + 16 * cchk) = kr[i]; *(LAS u32x4*)(vl + (crow_ + 8 * i) * VP + 16 * cchk) = vr[i]; }
            asm volatile("s_waitcnt lgkmcnt(0)" ::: "memory");
            bf16x8 kf[4];
#pragma unroll
            for (int st = 0; st < 4; ++st) kf[st] = *(const LAS bf16x8*)(kl + ql * KP + 32 * st + 16 * h);
            const int dq = tq - kb - dil * 4 * h;
            const float binit = -slope2 * (float)dq, sd = slope2 * (float)dil;
            f32x16 sacc;
#pragma unroll
            for (int i = 0; i < 16; ++i) {
                const int ci = (i & 3) + 8 * (i >> 2);
                const int dist = dq - dil * ci;
                sacc[i] = ((unsigned)dist <= (unsigned)lim) ? fmaf(sd, (float)ci, binit) : -INFINITY;
            }
#pragma unroll
            for (int st = 0; st < 4; ++st) sacc = MFMA32(kf[st], qf[st], sacc);
            float mloc = fmaxf(fmaxf(fmaxf(sacc[0], sacc[1]), fmaxf(sacc[2], sacc[3])), fmaxf(fmaxf(sacc[4], sacc[5]), fmaxf(sacc[6], sacc[7])));
            mloc = fmaxf(mloc, fmaxf(fmaxf(fmaxf(sacc[8], sacc[9]), fmaxf(sacc[10], sacc[11])), fmaxf(fmaxf(sacc[12], sacc[13]), fmaxf(sacc[14], sacc[15]))));
            { auto sw = __builtin_amdgcn_permlane32_swap(__builtin_bit_cast(unsigned, mloc), __builtin_bit_cast(unsigned, mloc), false, false);
              mloc = fmaxf(__builtin_bit_cast(float, (unsigned)sw[0]), __builtin_bit_cast(float, (unsigned)sw[1])); }
            const float mnew = fmaxf(mrun, mloc);
            const float alpha = fexp2(mrun - mnew);
            mrun = mnew;
            float ps0 = 0.f, ps1 = 0.f;
#pragma unroll
            for (int i = 0; i < 16; i += 2) { const float p0 = fexp2(sacc[i] - mnew), p1 = fexp2(sacc[i + 1] - mnew); sacc[i] = p0; sacc[i + 1] = p1; ps0 += p0; ps1 += p1; }
            lrun = lrun * alpha + (ps0 + ps1);
            if (__builtin_amdgcn_ballot_w64(alpha != 1.0f) != 0ull) {
#pragma unroll
                for (int i = 0; i < 16; ++i) { o0[i] *= alpha; o1[i] *= alpha; }
            }
            bf16x8 pb[2];
#pragma unroll
            for (int s = 0; s < 2; ++s) {
                u32x4 w; w.x = pk2(sacc[8 * s + 0], sacc[8 * s + 1]); w.y = pk2(sacc[8 * s + 2], sacc[8 * s + 3]); w.z = pk2(sacc[8 * s + 4], sacc[8 * s + 5]); w.w = pk2(sacc[8 * s + 6], sacc[8 * s + 7]);
                pb[s] = __builtin_bit_cast(bf16x8, w);
            }
            asm volatile("s_waitcnt lgkmcnt(0)" ::: "memory");
#pragma unroll
            for (int s = 0; s < 2; ++s) {
                const s16x4 a00 = tr_read(vl + traddr + (16 * s) * VP), a01 = tr_read(vl + traddr + (16 * s + 8) * VP);
                const s16x4 a10 = tr_read(vl + traddr + (16 * s) * VP + 64), a11 = tr_read(vl + traddr + (16 * s + 8) * VP + 64);
                const bf16x8 va0 = __builtin_shufflevector(a00, a01, 0, 1, 2, 3, 4, 5, 6, 7), va1 = __builtin_shufflevector(a10, a11, 0, 1, 2, 3, 4, 5, 6, 7);
                o0 = MFMA32(va0, pb[s], o0);
                o1 = MFMA32(va1, pb[s], o1);
            }
            asm volatile("s_waitcnt lgkmcnt(0)" ::: "memory");
        }
    }
    const float ltot = lrun + __shfl_xor(lrun, 32);
    const float inv = 1.0f / ltot;
    bf16* op = AS + rowq * 256 + islot * 64 + 4 * h;
#pragma unroll
    for (int g4 = 0; g4 < 4; ++g4) {
        *(u32x2*)(op + 8 * g4) = (u32x2){pk2(o0[4 * g4] * inv, o0[4 * g4 + 1] * inv), pk2(o0[4 * g4 + 2] * inv, o0[4 * g4 + 3] * inv)};
        *(u32x2*)(op + 32 + 8 * g4) = (u32x2){pk2(o1[4 * g4] * inv, o1[4 * g4 + 1] * inv), pk2(o1[4 * g4 + 2] * inv, o1[4 * g4 + 3] * inv)};
    }
}

__device__ __forceinline__ void attn_sample_unit(const Args& a, const bf16* Z, int layer, int task, int g, LAS float* sc, LAS float* part, int lane) {
    const int j = task & 3, islot = (task >> 2) & 3, b = task >> 4;
    const size_t rowq = (size_t)MP + b * DS + j;
    const int sub = lane >> 4, l16 = lane & 15;
    const int dil = 1 << (2 * g), W = 128 << (2 * g);
    const float slope2 = alibi_slope2(g * 4 + islot);
    const float* cache = (g == 0 ? a.in[2] : g == 1 ? a.in[3] : a.in[4]) + ((size_t)(layer * DB + b) * W) * 512 + islot * 64 + 4 * l16;
    f32x4 q4;
    { const u32x2 qw = *(const u32x2*)(Z + rowq * NIN + C_Q + g * 256 + islot * 64 + 4 * l16); q4 = (f32x4){bflo(qw.x), bfhi(qw.x), bflo(qw.y), bfhi(qw.y)}; }
    const int nnew = g == 0 ? j + 1 : 1;
    float sn = -INFINITY; f32x4 vn4;
    {   const int i = sub < nnew ? sub : 0;
        const bf16* rp = Z + ((size_t)MP + b * DS + (j - i * dil)) * NIN + g * 256 + islot * 64 + 4 * l16;
        const u32x2 kw = *(const u32x2*)(rp + C_K), vw = *(const u32x2*)(rp + C_V);
        float d = q4[0] * bflo(kw.x) + q4[1] * bfhi(kw.x) + q4[2] * bflo(kw.y) + q4[3] * bfhi(kw.y);
        d += __shfl_xor(d, 1); d += __shfl_xor(d, 2); d += __shfl_xor(d, 4); d += __shfl_xor(d, 8);
        if (sub < nnew) sn = d - slope2 * (float)(i * dil);
        vn4 = (f32x4){bflo(vw.x), bfhi(vw.x), bflo(vw.y), bfhi(vw.y)};
    }
    float gmax = sn;
    const size_t stride = (size_t)4 * dil * 512;
    const float* kp = cache + (size_t)(W + j - (nnew + sub) * dil) * 512;
#pragma unroll 1
    for (int hb = 0; hb < 2; ++hb) {
        f32x4 kw[16];
#pragma unroll
        for (int it = 0; it < 16; ++it) kw[it] = *(const f32x4*)(kp - (size_t)(16 * hb + it) * stride);
#pragma unroll
        for (int it = 0; it < 16; ++it) {
            const int i = nnew + 4 * (16 * hb + it) + sub;
            float d = (q4[0] * kw[it][0] + q4[1] * kw[it][1]) + (q4[2] * kw[it][2] + q4[3] * kw[it][3]);
            d += __shfl_xor(d, 1); d += __shfl_xor(d, 2); d += __shfl_xor(d, 4); d += __shfl_xor(d, 8);
            const float sv = i <= 128 ? d - slope2 * (float)(i * dil) : -INFINITY;
            sc[(16 * hb + it) * 64 + lane] = sv; gmax = fmaxf(gmax, sv);
        }
    }
    gmax = fmaxf(gmax, __shfl_xor(gmax, 16)); gmax = fmaxf(gmax, __shfl_xor(gmax, 32));
    float lrun; f32x4 o4;
    { const float p = fexp2(sn - gmax); lrun = p; o4 = vn4 * p; }
    asm volatile("s_waitcnt lgkmcnt(0)" ::: "memory");
#pragma unroll 1
    for (int hb = 0; hb < 2; ++hb) {
        f32x4 vw[16];
#pragma unroll
        for (int it = 0; it < 16; ++it) vw[it] = *(const f32x4*)(kp + 256 - (size_t)(16 * hb + it) * stride);
#pragma unroll
        for (int it = 0; it < 16; ++it) { const float p = fexp2(sc[(16 * hb + it) * 64 + lane] - gmax); lrun += p; o4 = o4 + vw[it] * p; }
    }
    lrun += __shfl_xor(lrun, 16); lrun += __shfl_xor(lrun, 32);
#pragma unroll
    for (int e = 0; e < 4; ++e) { float v = o4[e]; v += __shfl_xor(v, 16); v += __shfl_xor(v, 32); o4[e] = v; }
    if (sub == 0) *(LAS f32x4*)(part + 4 + 4 * l16) = o4;
    if (lane == 0) { part[0] = gmax; part[1] = lrun; }
    asm volatile("s_waitcnt lgkmcnt(0)" ::: "memory");
}
__device__ __forceinline__ void attn_sample_combine(bf16* AS, int task, const LAS float* part3, int d) {
    const int j = task & 3, islot = (task >> 2) & 3, b = task >> 4;
    const size_t rowq = (size_t)MP + b * DS + j;
    const float m0 = part3[0], m1 = part3[72], m2 = part3[144];
    const float M = fmaxf(m0, fmaxf(m1, m2));
    const float w0 = fexp2(m0 - M), w1 = fexp2(m1 - M), w2 = fexp2(m2 - M);
    const float L = w0 * part3[1] + w1 * part3[73] + w2 * part3[145];
    const float o = w0 * part3[4 + d] + w1 * part3[76 + d] + w2 * part3[148 + d];
    AS[rowq * 256 + islot * 64 + d] = (bf16)f2bf(o / L);
}

constexpr int GP = 320;
__device__ __forceinline__ void gmlp_prompt_unit(const Args& a, const bf16* Z, bf16* AS, const float* ssv, int layer, int unit, LAS unsigned char* lds, int tid, int wave, int lane) {
    const int gg = unit & 3, n = unit >> 2, m0 = n * 128;
    const bf16* Wt = (const bf16*)(a.ws + WS_W + (size_t)layer * WL_STRIDE + WL_TRIL) + gg * 128 * 128;
    const float* gain = a.in[11] + layer * 512 + gg * 128;
    const float* bias = a.in[13] + (layer * 4 + gg) * 128;
    __syncthreads();
    {
        const int row = tid >> 2, qt = tid & 3;
        const float rv = rsqrtf(ssv[m0 + row] * (1.0f / 512.0f) + EPS);
        const bf16* src = Z + (size_t)(m0 + row) * NIN + C_VS + gg * 128 + 32 * qt;
#pragma unroll
        for (int jj = 0; jj < 4; ++jj) {
            const u32x4 w = *(const u32x4*)(src + 8 * jj);
            const f32x4 g0 = *(const f32x4*)(gain + 32 * qt + 8 * jj), g1 = *(const f32x4*)(gain + 32 * qt + 8 * jj + 4);
            u32x4 o;
            o.x = pk2(bflo(w.x) * rv * g0[0], bfhi(w.x) * rv * g0[1]); o.y = pk2(bflo(w.y) * rv * g0[2], bfhi(w.y) * rv * g0[3]);
            o.z = pk2(bflo(w.z) * rv * g1[0], bfhi(w.z) * rv * g1[1]); o.w = pk2(bflo(w.w) * rv * g1[2], bfhi(w.w) * rv * g1[3]);
            *(LAS u32x4*)(lds + row * GP + (32 * qt + 8 * jj) * 2) = o;
        }
    }
    __syncthreads();
    const int ct = wave & 3, tl = lane & 31, h = lane >> 5;
    const int i16 = lane & 15, tq_ = i16 >> 2, tp = i16 & 3, blk = (lane >> 4) & 1;
    const int traddr = (8 * h + tq_) * GP + (32 * ct + 16 * blk + 4 * tp) * 2;
#pragma unroll
    for (int half = 0; half < 2; ++half) {
        const int tt = half == 0 ? (wave >> 2) : 3 - (wave >> 2);
        f32x16 acc;
#pragma unroll
        for (int i = 0; i < 16; ++i) acc[i] = 0.f;
        const bf16* wrow = Wt + (size_t)(32 * tt + tl) * 128 + 8 * h;
        const int nks = 2 * (tt + 1);
        bf16x8 wb[8];
#pragma unroll
        for (int ks = 0; ks < 8; ++ks) if (ks < nks) wb[ks] = *(const bf16x8*)(wrow + 16 * ks);
#pragma unroll
        for (int ks = 0; ks < 8; ++ks) if (ks < nks) {
            const s16x4 a0 = tr_read(lds + traddr + (16 * ks) * GP), a1 = tr_read(lds + traddr + (16 * ks + 4) * GP);
            const bf16x8 va = __builtin_shufflevector(a0, a1, 0, 1, 2, 3, 4, 5, 6, 7);
            acc = MFMA32(va, wb[ks], acc);
        }
        const int trow = 32 * tt + tl;
        const float bs = bias[trow];
        const size_t row = (size_t)m0 + trow;
#pragma unroll
        for (int i4 = 0; i4 < 4; ++i4) {
            const int c = 32 * ct + 8 * i4 + 4 * h;
            const u32x2 uw = *(const u32x2*)(Z + row * NIN + C_U + gg * 128 + c);
            const float z0 = (acc[4 * i4] + bs) * bflo(uw.x), z1 = (acc[4 * i4 + 1] + bs) * bfhi(uw.x), z2 = (acc[4 * i4 + 2] + bs) * bflo(uw.y), z3 = (acc[4 * i4 + 3] + bs) * bfhi(uw.y);
            *(u32x2*)(AS + row * 512 + gg * 128 + c) = (u32x2){pk2(z0, z1), pk2(z2, z3)};
        }
    }
}
__device__ __forceinline__ void gmlp_prompt_pair(const Args& a, const bf16* Z, bf16* AS, const float* ssv, int layer, int u0, LAS unsigned char* lds, int tid, int wave, int lane) {
    const int gg = u0 & 3;
    const bf16* Wt = (const bf16*)(a.ws + WS_W + (size_t)layer * WL_STRIDE + WL_TRIL) + gg * 128 * 128;
    const float* gain = a.in[11] + layer * 512 + gg * 128;
    const float* bias = a.in[13] + (layer * 4 + gg) * 128;
    const int row = tid >> 2, qt = tid & 3;
    const int ct = wave & 3, tl = lane & 31, h = lane >> 5;
    u32x4 vt[2][4]; float sv[2];
#pragma unroll
    for (int uu = 0; uu < 2; ++uu) {
        const int m0 = ((u0 + 256 * uu) >> 2) * 128;
        sv[uu] = ssv[m0 + row];
        const bf16* src = Z + (size_t)(m0 + row) * NIN + C_VS + gg * 128 + 32 * qt;
#pragma unroll
        for (int jj = 0; jj < 4; ++jj) vt[uu][jj] = *(const u32x4*)(src + 8 * jj);
    }
    f32x4 g0[4], g1[4];
#pragma unroll
    for (int jj = 0; jj < 4; ++jj) { g0[jj] = *(const f32x4*)(gain + 32 * qt + 8 * jj); g1[jj] = *(const f32x4*)(gain + 32 * qt + 8 * jj + 4); }
    const int ttA = wave >> 2, ttB = 3 - (wave >> 2);
    bf16x8 wbA[4], wbB[8];
    {   const bf16* wrA = Wt + (size_t)(32 * ttA + tl) * 128 + 8 * h; const bf16* wrB = Wt + (size_t)(32 * ttB + tl) * 128 + 8 * h;
#pragma unroll
        for (int ks = 0; ks < 4; ++ks) if (ks < 2 * (ttA + 1)) wbA[ks] = *(const bf16x8*)(wrA + 16 * ks);
#pragma unroll
        for (int ks = 0; ks < 8; ++ks) if (ks < 2 * (ttB + 1)) wbB[ks] = *(const bf16x8*)(wrB + 16 * ks);
    }
    u32x2 uw[2][2][4]; float bs[2];
    bs[0] = bias[32 * ttA + tl]; bs[1] = bias[32 * ttB + tl];
#pragma unroll
    for (int uu = 0; uu < 2; ++uu)
#pragma unroll
        for (int hf = 0; hf < 2; ++hf) {
            const size_t r = (size_t)((u0 + 256 * uu) >> 2) * 128 + 32 * (hf == 0 ? ttA : ttB) + tl;
#pragma unroll
            for (int i4 = 0; i4 < 4; ++i4) uw[uu][hf][i4] = *(const u32x2*)(Z + r * NIN + C_U + gg * 128 + 32 * ct + 8 * i4 + 4 * h);
        }
    __syncthreads();
#pragma unroll
    for (int uu = 0; uu < 2; ++uu) {
        const float rv = rsqrtf(sv[uu] * (1.0f / 512.0f) + EPS);
#pragma unroll
        for (int jj = 0; jj < 4; ++jj) {
            const u32x4 w = vt[uu][jj];
            u32x4 o;
            o.x = pk2(bflo(w.x) * rv * g0[jj][0], bfhi(w.x) * rv * g0[jj][1]); o.y = pk2(bflo(w.y) * rv * g0[jj][2], bfhi(w.y) * rv * g0[jj][3]);
            o.z = pk2(bflo(w.z) * rv * g1[jj][0], bfhi(w.z) * rv * g1[jj][1]); o.w = pk2(bflo(w.w) * rv * g1[jj][2], bfhi(w.w) * rv * g1[jj][3]);
            *(LAS u32x4*)(lds + uu * (128 * GP) + row * GP + (32 * qt + 8 * jj) * 2) = o;
        }
    }
    __syncthreads();
    const int i16 = lane & 15, tq_ = i16 >> 2, tp = i16 & 3, blk = (lane >> 4) & 1;
    const int traddr = (8 * h + tq_) * GP + (32 * ct + 16 * blk + 4 * tp) * 2;
#pragma unroll
    for (int uu = 0; uu < 2; ++uu)
#pragma unroll
        for (int hf = 0; hf < 2; ++hf) {
            const int tt = hf == 0 ? ttA : ttB;
            const LAS unsigned char* tile = lds + uu * (128 * GP);
            f32x16 acc;
#pragma unroll
            for (int i = 0; i < 16; ++i) acc[i] = 0.f;
            if (hf == 0) {
#pragma unroll
                for (int ks = 0; ks < 4; ++ks) if (ks < 2 * (tt + 1)) {
                    const s16x4 a0 = tr_read(tile + traddr + (16 * ks) * GP), a1 = tr_read(tile + traddr + (16 * ks + 4) * GP);
                    acc = MFMA32(__builtin_shufflevector(a0, a1, 0, 1, 2, 3, 4, 5, 6, 7), wbA[ks], acc);
                }
            } else {
#pragma unroll
                for (int ks = 0; ks < 8; ++ks) if (ks < 2 * (tt + 1)) {
                    const s16x4 a0 = tr_read(tile + traddr + (16 * ks) * GP), a1 = tr_read(tile + traddr + (16 * ks + 4) * GP);
                    acc = MFMA32(__builtin_shufflevector(a0, a1, 0, 1, 2, 3, 4, 5, 6, 7), wbB[ks], acc);
                }
            }
            const size_t r = (size_t)((u0 + 256 * uu) >> 2) * 128 + 32 * tt + tl;
            const float b_ = bs[hf];
#pragma unroll
            for (int i4 = 0; i4 < 4; ++i4) {
                const int c = 32 * ct + 8 * i4 + 4 * h;
                const u32x2 uv = uw[uu][hf][i4];
                const float z0 = (acc[4 * i4] + b_) * bflo(uv.x), z1 = (acc[4 * i4 + 1] + b_) * bfhi(uv.x), z2 = (acc[4 * i4 + 2] + b_) * bflo(uv.y), z3 = (acc[4 * i4 + 3] + b_) * bfhi(uv.y);
                *(u32x2*)(AS + r * 512 + gg * 128 + c) = (u32x2){pk2(z0, z1), pk2(z2, z3)};
            }
        }
}
__device__ __forceinline__ void gmlp_sample_unit(const Args& a, const bf16* Z, bf16* AS, const float* ssv, int layer, int b, int tid) {
    const int c = tid, gg = c >> 7;
    const float gain = a.in[11][layer * 512 + c];
    const float* Wf = a.in[12] + (size_t)(layer * 4 + gg) * 128 * 128;
    const float* bias = a.in[13] + (layer * 4 + gg) * 128;
    float vn[4];
#pragma unroll
    for (int j = 0; j < 4; ++j) {
        const size_t row = (size_t)MP + b * DS + j;
        const float rv = rsqrtf(ssv[row] * (1.0f / 512.0f) + EPS);
        vn[j] = bflo((unsigned)Z[row * NIN + C_VS + c]) * rv * gain;
        a.out[O_GV + ((size_t)(layer * DB + b) * DS + j) * 512 + c] = vn[j];
    }
#pragma unroll
    for (int j = 0; j < 4; ++j) {
        const size_t row = (size_t)MP + b * DS + j;
        float z = bias[j];
#pragma unroll
        for (int s = 0; s < 4; ++s) if (s <= j) z = fmaf(Wf[j * 128 + s], vn[s], z);
        const float uu = bflo((unsigned)Z[row * NIN + C_U + c]);
        AS[row * 512 + c] = (bf16)f2bf(uu * z);
    }
}

__device__ __forceinline__ void phase_mixer(const Args& a, int layer, LAS unsigned char* lds, int tid, int wave, int lane) {
    const bf16* Z = (const bf16*)(a.ws + WS_Z); bf16* AT = (bf16*)(a.ws + WS_ATT); bf16* SP = (bf16*)(a.ws + WS_SP);
    const float* ssv = (const float*)(a.ws + WS_SS) + (7 + layer) * MPAD;
    const int G = gridDim.x, wg = blockIdx.x;
#ifndef MX_MASK
#define MX_MASK 15
#endif
    if (MX_MASK & 1) for (int tk = wg * NWAVES + wave; tk < 2048; tk += G * NWAVES) { const int task = (G == 256) ? ((wg & 7) * 256 + (wg >> 3) * NWAVES + wave) : tk; attn_prompt_task(Z, (const bf16*)(a.ws + WS_KC), (const bf16*)(a.ws + WS_VC), AT, task, lds + wave * ATT_WAVE_LDS, lane); }
    if (MX_MASK & 2) for (int base = wg * 2; base < 512; base += G * 2) {
        LAS float* part = (LAS float*)(lds + 98304);
        if (wave < 6) attn_sample_unit(a, Z, layer, base + wave / 3, wave % 3, (LAS float*)(lds + wave * ATT_WAVE_LDS), part + wave * 72, lane);
        __syncthreads();
        if (tid < 128) attn_sample_combine(AT, base + (tid >> 6), part + (tid >> 6) * 216, tid & 63);
    }
    if (MX_MASK & 4) { if (G == 256) gmlp_prompt_pair(a, Z, SP, ssv, layer, wg, lds, tid, wave, lane); else for (int unit = wg; unit < 512; unit += G) gmlp_prompt_unit(a, Z, SP, ssv, layer, unit, lds, tid, wave, lane); }
    if (MX_MASK & 8) for (int b = G - 1 - wg; b < DB; b += G) gmlp_sample_unit(a, Z, SP, ssv, layer, b, tid);
}

#define MFMA16(a, b, c) __builtin_amdgcn_mfma_f32_16x16x32_bf16((a), (b), (c), 0, 0, 0)
__device__ __forceinline__ void skinny_partial(const bf16* A, const bf16* Bt, int K, int r0, int n0, int wave, int lane, f32x4& acc0, f32x4& acc1) {
    const int ksl = K >> 3, nst = ksl >> 5;
    const bf16* ap = A + (size_t)(r0 + (lane & 15)) * K + wave * ksl + 8 * (lane >> 4);
    const bf16* bp0 = Bt + (size_t)(n0 + (lane & 15)) * K + wave * ksl + 8 * (lane >> 4);
    const bf16* bp1 = bp0 + (size_t)16 * K;
#pragma unroll 1
    for (int s0 = 0; s0 < nst; s0 += 6) {
        bf16x8 av[6], b0[6], b1[6];
#pragma unroll
        for (int u = 0; u < 6; ++u) if (s0 + u < nst) { av[u] = *(const bf16x8*)(ap + 32 * (s0 + u)); b0[u] = *(const bf16x8*)(bp0 + 32 * (s0 + u)); b1[u] = *(const bf16x8*)(bp1 + 32 * (s0 + u)); }
#pragma unroll
        for (int u = 0; u < 6; ++u) if (s0 + u < nst) { acc0 = MFMA16(b0[u], av[u], acc0); acc1 = MFMA16(b1[u], av[u], acc1); }
    }
}
template <int MODE> __device__ __forceinline__ void skinny_phase(LAS unsigned char* lds, const bf16* A, const bf16* Bt, int K, const bf16* A2, const bf16* Bt2, int K2,
                                                                  const float* XinS  , bf16* XB, float* ssn, float alpha, bf16* MIX, const bf16* Z, int tid, int wave, int lane) {
    LAS float* red = (LAS float*)lds;
    const int G = gridDim.x;
    for (int piece = blockIdx.x; piece < 256; piece += G) {
        const int rb = piece >> 5, cb = piece & 31, r0 = MP + 16 * rb, n0 = 32 * cb;
        __syncthreads();
        f32x4 a0 = (f32x4){0.f, 0.f, 0.f, 0.f}, a1 = a0;
        skinny_partial(A, Bt, K, r0, n0, wave, lane, a0, a1);
        *(LAS f32x4*)(red + wave * 512 + lane * 8) = a0; *(LAS f32x4*)(red + wave * 512 + lane * 8 + 4) = a1;
        if (MODE == 1) {
            f32x4 c0 = (f32x4){0.f, 0.f, 0.f, 0.f}, c1 = c0;
            skinny_partial(A2, Bt2, K2, r0, n0, wave, lane, c0, c1);
            *(LAS f32x4*)(red + 4096 + wave * 512 + lane * 8) = c0; *(LAS f32x4*)(red + 4096 + wave * 512 + lane * 8 + 4) = c1;
        }
        __syncthreads();
        const int m = tid >> 5, c = tid & 31, e = (((c & 15) >> 2) * 16 + m) * 8 + (c >> 4) * 4 + (c & 3);
        float s1 = 0.f, s2 = 0.f;
#pragma unroll
        for (int w = 0; w < 8; ++w) { s1 += red[w * 512 + e]; if (MODE == 1) s2 += red[4096 + w * 512 + e]; }
        const size_t row = (size_t)r0 + m; const int col = n0 + c;
        if (MODE == 0) {
            const float x = (XinS ? XinS[(size_t)(16 * rb + m) * DM + col] : bflo((unsigned)XB[row * DM + col])) + alpha * s1;
            XB[row * DM + col] = (bf16)f2bf(x);
            float q = x * x;
            q += __shfl_xor(q, 1); q += __shfl_xor(q, 2); q += __shfl_xor(q, 4); q += __shfl_xor(q, 8); q += __shfl_xor(q, 16);
            if (c == 0) unsafeAtomicAdd(ssn + row, q);
        } else {
            const float ga = bflo((unsigned)Z[row * NIN + C_GA + col]), gb = bflo((unsigned)Z[row * NIN + C_GB + col]);
            MIX[row * DM + col] = (bf16)f2bf(ga * s1 + gb * s2);
        }
    }
}

__device__ __forceinline__ void phase_final(const Args& a, int gw, int NGW, int lane) {
    const bf16* XB = (const bf16*)(a.ws + WS_XB); const float* ss = (const float*)(a.ws + WS_SS) + 6 * MPAD; const float* gain = a.in[21];
    const int mlo = ((int)gridDim.x == (MP / 256) * (DM / 256)) ? MP : 0;
    for (int m = mlo + gw; m < MR; m += NGW) {
        const float r = rsqrtf(ss[m] * (1.0f / DM) + EPS);
#pragma unroll
        for (int j = 0; j < 4; ++j) { const u32x2 w = *(const u32x2*)(XB + (size_t)m * DM + 4 * lane + 256 * j); const f32x4 v = (f32x4){bflo(w.x), bfhi(w.x), bflo(w.y), bfhi(w.y)}, g = *(const f32x4*)(gain + 4 * lane + 256 * j);
            *(f32x4*)(a.out + (size_t)m * DM + 4 * lane + 256 * j) = v * r * g; }
    }
}

constexpr int N_PHASES = 18;
#ifndef MK_MASK
#define MK_MASK 0xFFFF
#endif
#ifndef PJ_MASK
#define PJ_MASK 3
#endif
template <int PH> __device__ __forceinline__ void run_phase(const Args& a, LAS unsigned char* lds) {
    int tid_ = threadIdx.x; asm volatile("" : "+v"(tid_));
    const int tid = tid_, lane = tid & 63, wave = __builtin_amdgcn_readfirstlane(tid >> 6);
    const int G = gridDim.x, wg = blockIdx.x;
    const int gw = wg * NWAVES + wave, NGW = G * NWAVES;
    unsigned char* ws = a.ws;
    float* SS = (float*)(ws + WS_SS);
    float* X = (float*)(ws + WS_X); bf16* XB = (bf16*)(ws + WS_XB); bf16* Zb = (bf16*)(ws + WS_Z); bf16* HB = (bf16*)(ws + WS_Z);
    bf16* ATb = (bf16*)(ws + WS_ATT); bf16* SPb = (bf16*)(ws + WS_SP); bf16* MIX = (bf16*)(ws + WS_MIX);
    if constexpr (PH == 0) { if (MK_MASK & 1) phase_prologue(a, lds, gw, NGW, lane, wave); }
    else if constexpr (PH == N_PHASES - 1) { if (MK_MASK & 2) phase_final(a, gw, NGW, lane); }
    else {
        constexpr int layer = (PH - 1) >> 3, sub = (PH - 1) & 7;
        unsigned char* wl = ws + WS_W + (size_t)layer * WL_STRIDE;
        pg8::StaticOrder S;
        if constexpr (sub == 0 || sub == 6) {
            if (MK_MASK & 4) {
            pg8::Gemm g{XB, (const bf16*)(wl + (sub == 0 ? WL_GU1 : WL_GU2)), MPAD, NGU, DM}; S.init(MPAD, NGU, G, wg);
            EpiGU E{HB, SS + (3 * layer + (sub == 0 ? 0 : 2)) * MPAD};
            pg8::gemm_phase<EpiGU, pg8::StaticOrder, true, true>(lds, g, S, E); }
        } else if constexpr (sub == 1 || sub == 7) {
            if (MK_MASK & 8) {
            pg8::Gemm g{HB, (const bf16*)(wl + (sub == 1 ? WL_DN1 : WL_DN2)), MP, DM, DFF}; S.init(MP, DM, G, wg);
            if constexpr (PH == N_PHASES - 2) {
                if (G * 1 == (MP / 256) * (DM / 256)) { EpiResFinal E{XB, a.out, SS + 6 * MPAD, (unsigned*)(ws + WS_PCNT), a.in[21], 0.5f}; pg8::gemm_phase<EpiResFinal, pg8::StaticOrder, true, true>(lds, g, S, E); }
                else { EpiResT<false> E{nullptr, XB, SS + 6 * MPAD, 0.5f}; pg8::gemm_phase<EpiResT<false>, pg8::StaticOrder, true, true>(lds, g, S, E); }
            } else {
            EpiResT<PH == 2> E{a.in[0], XB, SS + (3 * layer + (sub == 1 ? 1 : 3)) * MPAD, 0.5f};
            pg8::gemm_phase<EpiResT<PH == 2>, pg8::StaticOrder, true, true>(lds, g, S, E); }
            skinny_phase<0>(lds, HB, (const bf16*)(wl + (sub == 1 ? WL_DN1 : WL_DN2)), DFF, nullptr, nullptr, 0, PH == 2 ? a.in[1] : nullptr, XB, SS + (3 * layer + (sub == 1 ? 1 : 3)) * MPAD, 0.5f, nullptr, nullptr, tid, wave, lane); }
        } else if constexpr (sub == 2) {
            if (MK_MASK & 16) {
            pg8::Gemm g{XB, (const bf16*)(wl + WL_IN), MPAD, NIN, DM}; S.init(MPAD, NIN, G, wg);
            EpiIn E{Zb, SS + (3 * layer + 1) * MPAD, SS + (7 + layer) * MPAD, a.out, layer, (bf16*)(ws + WS_KC), (bf16*)(ws + WS_VC)};
            pg8::gemm_phase<EpiIn, pg8::StaticOrder, true, true>(lds, g, S, E); }
        } else if constexpr (sub == 3) {
            if (MK_MASK & 32) phase_mixer(a, layer, lds, tid, wave, lane);
        } else if constexpr (sub == 4) {
            if (MK_MASK & 64) {
            S.init(MP, DM, G, wg);
            if (PJ_MASK & 1) { pg8::Gemm g{ATb, (const bf16*)(wl + WL_PA), MP, DM, 256}; EpiProj<0> E{MIX, Zb}; pg8::gemm_phase<EpiProj<0>, pg8::StaticOrder, true, true>(lds, g, S, E); }
            __syncthreads();
            if (PJ_MASK & 2) { pg8::Gemm g{SPb, (const bf16*)(wl + WL_PS), MP, DM, 512}; EpiProj<1> E{MIX, Zb}; pg8::gemm_phase<EpiProj<1>, pg8::StaticOrder, true, true>(lds, g, S, E); }
            skinny_phase<1>(lds, ATb, (const bf16*)(wl + WL_PA), 256, SPb, (const bf16*)(wl + WL_PS), 512, nullptr, nullptr, nullptr, 0.f, MIX, Zb, tid, wave, lane); }
        } else {
            if (MK_MASK & 128) {
            pg8::Gemm g{MIX, (const bf16*)(wl + WL_WO), MP, DM, DM}; S.init(MP, DM, G, wg);
            EpiResT<false> E{nullptr, XB, SS + (3 * layer + 2) * MPAD, 1.0f};
            pg8::gemm_phase<EpiResT<false>, pg8::StaticOrder, true, true>(lds, g, S, E);
            skinny_phase<0>(lds, MIX, (const bf16*)(wl + WL_WO), DM, nullptr, nullptr, 0, nullptr, XB, SS + (3 * layer + 2) * MPAD, 1.0f, nullptr, nullptr, tid, wave, lane); }
        }
    }
}
template <int PH> __device__ __forceinline__ void run_from(const Args& a, LAS unsigned char* lds, int ph_lo, int ph_hi, const XcdBarrier& bar) {
    if constexpr (PH < N_PHASES) {
        if (ph_lo <= PH && PH < ph_hi) {
            if (PH > ph_lo) xcd_barrier(bar);
            run_phase<PH>(a, lds);
#ifndef PROBE_REP
#define PROBE_REP 0
#endif
            { constexpr int sub_ = (PH - 1) & 7; constexpr bool mid_ = PH > 0 && PH < N_PHASES - 1;
              if ((PH == 0 && (PROBE_REP & 1)) || (mid_ && (sub_ == 0 || sub_ == 6) && (PROBE_REP & 4)) || (mid_ && sub_ == 3 && (PROBE_REP & 32)) || (mid_ && sub_ == 4 && (PROBE_REP & 64))) { __syncthreads(); run_phase<PH>(a, lds); } }
        }
        run_from<PH + 1>(a, lds, ph_lo, ph_hi, bar);
    }
}
__global__ void __launch_bounds__(NTHR, 2) mk_fwd(Args a) {
    extern __shared__ __attribute__((aligned(16))) unsigned char lds_raw[];
    LAS unsigned char* lds = (LAS unsigned char*)lds_raw;
    if (a.ph_lo < 0) cg::this_grid().sync();
    if (threadIdx.x < 2) ((volatile LAS unsigned*)(lds + LDS_MISC))[threadIdx.x] = 0u;
    __syncthreads();
    XcdBarrier bar; bar.bar = (unsigned*)(a.ws + WS_BAR); bar.x = 0; bar.st = (volatile LAS unsigned*)(lds + LDS_MISC);
    if (a.ph_hi - a.ph_lo > 1) bar = xcd_barrier_post((unsigned*)(a.ws + WS_BAR), (volatile LAS unsigned*)(lds + LDS_MISC));
    run_from<0>(a, lds, a.ph_lo, a.ph_hi, bar);
}

#ifndef MK_MULTI
#define MK_MULTI 0
#endif
extern "C" void kernel_launch(void* const* d_in, const int* in_sizes, int n_in, void* d_out, int out_size, void* d_ws, size_t ws_size, hipStream_t stream) {
    static int grid = 0;
    if (grid == 0) {
        if (n_in != 22 || (size_t)out_size != O_TOTAL || ws_size < WS_END) { fprintf(stderr, "kernel_launch: unexpected shapes n_in %d out %d ws %zu (need %zu)\n", n_in, out_size, ws_size, (size_t)WS_END); grid = -1; return; }
        int dev = 0, cus = 0, per_cu = 0;
        hipGetDevice(&dev); hipDeviceGetAttribute(&cus, hipDeviceAttributeMultiprocessorCount, dev);
        if (hipFuncSetAttribute((const void*)mk_fwd, hipFuncAttributeMaxDynamicSharedMemorySize, LDS_BYTES) != hipSuccess) { fprintf(stderr, "kernel_launch: hipFuncSetAttribute failed\n"); grid = -1; return; }
        if (hipOccupancyMaxActiveBlocksPerMultiprocessor(&per_cu, (const void*)mk_fwd, NTHR, LDS_BYTES) != hipSuccess || per_cu < 1) { fprintf(stderr, "kernel_launch: occupancy query failed (%d)\n", per_cu); (void)hipGetLastError(); per_cu = 1; }
        grid = cus * 1;
        if (per_cu < 1) grid = -1;
    }
    if (grid < 0) return;
    if (hipMemsetAsync((char*)d_ws + WS_CTL0, 0, WS_CTL_BYTES, stream) != hipSuccess) { fprintf(stderr, "kernel_launch: hipMemsetAsync failed\n"); return; }
    Args a{};
    for (int i = 0; i < 22; ++i) a.in[i] = (const float*)d_in[i];
    a.out = (float*)d_out; a.ws = (unsigned char*)d_ws;
#if MK_MULTI
    for (int ph = 0; ph < N_PHASES; ++ph) { a.ph_lo = ph; a.ph_hi = ph + 1; hipLaunchKernelGGL(mk_fwd, dim3(grid), dim3(NTHR), LDS_BYTES, stream, a); }
#else
    a.ph_lo = 0; a.ph_hi = N_PHASES;
    void* args[] = {&a};
    hipError_t e = hipLaunchCooperativeKernel((const void*)mk_fwd, dim3(grid), dim3(NTHR), args, LDS_BYTES, stream);
    if (e != hipSuccess) fprintf(stderr, "cooperative launch failed: %s (grid %d)\n", hipGetErrorString(e), grid);
#endif
}
```

```cpp
#include <hip/hip_runtime.h>
#include <hip/hip_cooperative_groups.h>
#include <cstdio>
#include <cstdint>
namespace cg = cooperative_groups;
namespace pg8 {
#define PG8_LAS __attribute__((address_space(3)))
typedef unsigned short bf16_t;
typedef short bf16x8 __attribute__((ext_vector_type(8)));
typedef float f32x4 __attribute__((ext_vector_type(4)));
typedef unsigned u32x4 __attribute__((ext_vector_type(4)));
constexpr int BM = 256, BK = 64, HALF = 128, HTB = HALF * BK * 2  , STAGE_BYTES = 8 * HTB, NXCD = 8, WGM = 8;

__host__ __device__ __forceinline__ int lds_byte(int r, int c) { const int st = (r >> 4) * 2 + (c >> 5), rr = r & 15, cc = c & 31, ob = rr * 64 + cc * 2; return st * 1024 + (ob ^ (((ob >> 9) & 1) << 5)); }
__host__ __device__ __forceinline__ void stage_rc(int b, int& R, int& C) { const int st = b / 1024, sb = b % 1024, swz = sb ^ (((sb >> 9) & 1) << 5); R = (st >> 1) * 16 + swz / 64; C = (st & 1) * 32 + (swz % 64) / 2; }
__host__ __device__ __forceinline__ int perm32(int rho) { const int n = rho >> 4, i = rho & 15; return 8 * (i >> 2) + 4 * n + (i & 3); }

struct Unit { int pm, pn; };
struct Gemm { const bf16_t* A; const bf16_t* Bt; int M, N, K; };

struct StaticOrder {
    int nM, nN, nwg, G, c;
    __host__ __device__ void init(int M, int N, int G_, int c_) { nM = M / BM; nN = N / BM; nwg = nM * nN; G = G_; c = c_; }
    __host__ __device__ bool next(int i, Unit& u) const {
        const long L = (long)i * G + c; if (L >= nwg) return false;
        int wgid = (int)L; { const int q = nwg / NXCD, r = nwg % NXCD, xcd = wgid % NXCD, off = wgid / NXCD; wgid = (xcd < r ? xcd * (q + 1) : r * (q + 1) + (xcd - r) * q) + off; }
        const int nig = WGM * nN, gid = wgid / nig, fm = gid * WGM, gsz = (nM - fm) < WGM ? (nM - fm) : WGM;
        u.pm = fm + ((wgid % nig) % gsz); u.pn = (wgid % nig) / gsz; return true;
    }
    __device__ __forceinline__ void a_ready(const Unit&) const {}
    __device__ __forceinline__ void done(const Unit&) const {}
};

__device__ __forceinline__ unsigned cvt_pk_bf16(float lo, float hi) { unsigned r; asm volatile("v_cvt_pk_bf16_f32 %0, %1, %2" : "=v"(r) : "v"(lo), "v"(hi)); return r; }
typedef float f32x2 __attribute__((ext_vector_type(2)));
template <class Epi, class Sched, bool ALIGN_EPI = false, bool SP2 = false>
__device__ __forceinline__ void gemm_phase(PG8_LAS unsigned char* lds, const Gemm g, const Sched& S, const Epi& E) {
    int tid_ = threadIdx.x; asm volatile("" : "+v"(tid_));
    const int tid = tid_, wid = __builtin_amdgcn_readfirstlane(tid >> 6), lane = tid & 63, wr = wid >> 2, wc = wid & 3, fr = lane & 15, fq = lane >> 4;
    int K_ = g.K; asm volatile("" : "+s"(K_));
    const int K = K_, nt = K / BK;
    unsigned voffA[2], voffB[2];
#pragma unroll
    for (int i = 0; i < 2; ++i) { int R, C; stage_rc(tid * 16 + i * 8192, R, C); const int Rb = Epi::PERM ? ((R & ~31) + perm32(R & 31)) : R;
        voffA[i] = (unsigned)(R * K + C) * 2u; voffB[i] = (unsigned)(Rb * K + C) * 2u; }
    const size_t kstep = (size_t)(BK * 2);
    const size_t hstep = (size_t)HALF * K * 2;
    const size_t tstep = 2 * hstep;
    const unsigned ldsw = (unsigned)wid * 1024u;
    const int aoff = lds_byte(wr * 64 + fr, fq * 8), boff = lds_byte(wc * 32 + fr, fq * 8);
#define PG8_SA(b, h) (((b) * 2 + (h)) * HTB)
#define PG8_SB(b, h) ((4 + (b) * 2 + (h)) * HTB)
#define PG8_STAGE(bufoff, gbase, voff) do { _Pragma("unroll") for (int _i = 0; _i < 2; ++_i) \
        __builtin_amdgcn_global_load_lds((const unsigned*)((const char*)(gbase) + (voff)[_i]), (PG8_LAS unsigned*)(lds + (bufoff) + ldsw + _i * 8192), 16, 0, 0); } while (0)
#define PG8_LDA(dst, b, h) do { _Pragma("unroll") for (int m = 0; m < 4; ++m) _Pragma("unroll") for (int k = 0; k < 2; ++k) dst[m][k] = *(const PG8_LAS bf16x8*)(lds + PG8_SA(b, h) + aoff + m * 2048 + k * 1024); } while (0)
#define PG8_LDB(dst, b, h) do { _Pragma("unroll") for (int n = 0; n < 2; ++n) _Pragma("unroll") for (int k = 0; k < 2; ++k) dst[n][k] = *(const PG8_LAS bf16x8*)(lds + PG8_SB(b, h) + boff + n * 2048 + k * 1024); } while (0)
#define PG8_MMA(ai, bj, At, Bt) do { __builtin_amdgcn_s_setprio(1); _Pragma("unroll") for (int m = 0; m < 4; ++m) _Pragma("unroll") for (int n = 0; n < 2; ++n) _Pragma("unroll") for (int k = 0; k < 2; ++k) \
        acc[ai][bj][m][n] = __builtin_amdgcn_mfma_f32_16x16x32_bf16(Bt[n][k], At[m][k], acc[ai][bj][m][n], 0, 0, 0); __builtin_amdgcn_s_setprio(0); } while (0)
#define PG8_WAIT_V(n) asm volatile("s_waitcnt vmcnt(" #n ")" ::: "memory")
#define PG8_WAIT_L(n) asm volatile("s_waitcnt lgkmcnt(" #n ")" ::: "memory")
#define PG8_BAR __builtin_amdgcn_s_barrier()
#define PG8_SCHED __builtin_amdgcn_sched_barrier(0)
    Unit cur, nxt; int ui = 0;
    if (!S.next(0, cur)) return;
    f32x4 acc[2][2][4][2];
#pragma unroll
    for (int a = 0; a < 2; ++a)
#pragma unroll
        for (int b = 0; b < 2; ++b)
#pragma unroll
            for (int m = 0; m < 4; ++m)
#pragma unroll
                for (int n = 0; n < 2; ++n) acc[a][b][m][n] = (f32x4){0.f, 0.f, 0.f, 0.f};
    bf16x8 At[4][2], B0[2][2], B1[2][2];
    const char* cA = (const char*)g.A + (size_t)cur.pm * tstep; const char* cB = (const char*)g.Bt + (size_t)cur.pn * tstep;
    S.a_ready(cur);
    if constexpr (SP2) {
        PG8_STAGE(PG8_SB(0, 0), cB, voffB); PG8_STAGE(PG8_SB(0, 1), cB + hstep, voffB); PG8_STAGE(PG8_SA(0, 0), cA, voffA); PG8_STAGE(PG8_SA(0, 1), cA + hstep, voffA);
        if (wr == 1) PG8_BAR;
        PG8_WAIT_V(2); PG8_BAR;
        PG8_STAGE(PG8_SB(1, 0), cB + kstep, voffB); PG8_STAGE(PG8_SA(1, 0), cA + kstep, voffA); PG8_STAGE(PG8_SB(1, 1), cB + hstep + kstep, voffB);
        PG8_WAIT_V(6); PG8_BAR;
    } else {
        PG8_STAGE(PG8_SB(0, 0), cB, voffB); PG8_STAGE(PG8_SA(0, 0), cA, voffA); PG8_STAGE(PG8_SB(0, 1), cB + hstep, voffB); PG8_STAGE(PG8_SA(0, 1), cA + hstep, voffA);
        if (wr == 1) PG8_BAR;
        PG8_WAIT_V(4); PG8_BAR;
        PG8_STAGE(PG8_SB(1, 0), cB + kstep, voffB); PG8_STAGE(PG8_SA(1, 0), cA + kstep, voffA); PG8_STAGE(PG8_SB(1, 1), cB + hstep + kstep, voffB);
        PG8_WAIT_V(6); PG8_BAR;
    }
    for (;;) {
        const bool has_next = S.next(ui + 1, nxt);
        const char* nA = has_next ? (const char*)g.A + (size_t)nxt.pm * tstep : cA; const char* nB = has_next ? (const char*)g.Bt + (size_t)nxt.pn * tstep : cB;
        for (int t = 0; t < nt; t += 2) {
            const bool last = (t == nt - 2);
            const char* a1 = cA + (size_t)(t + 1) * kstep;
            const char* a2 = last ? nA : cA + (size_t)(t + 2) * kstep; const char* b2 = last ? nB : cB + (size_t)(t + 2) * kstep;
            const char* a3 = a2 + kstep; const char* b3 = b2 + kstep;
            if (last && has_next) S.a_ready(nxt);
            if constexpr (SP2) {
            PG8_LDB(B0, 0, 0); PG8_LDB(B1, 0, 1); PG8_SCHED; PG8_LDA(At, 0, 0); PG8_STAGE(PG8_SA(1, 1), a1 + hstep, voffA);
            PG8_WAIT_V(8); PG8_WAIT_L(0); PG8_BAR; PG8_MMA(0, 0, At, B0); PG8_MMA(0, 1, At, B1); PG8_BAR; PG8_SCHED;
            PG8_LDA(At, 0, 1); PG8_STAGE(PG8_SB(0, 0), b2, voffB); PG8_STAGE(PG8_SB(0, 1), b2 + hstep, voffB); PG8_STAGE(PG8_SA(0, 0), a2, voffA);
            PG8_WAIT_V(8); PG8_WAIT_L(0); PG8_BAR; PG8_MMA(1, 0, At, B0); PG8_MMA(1, 1, At, B1); PG8_BAR; PG8_SCHED;
            PG8_LDB(B0, 1, 0); PG8_LDB(B1, 1, 1); PG8_SCHED; PG8_LDA(At, 1, 0); PG8_STAGE(PG8_SA(0, 1), a2 + hstep, voffA);
            PG8_WAIT_V(8); PG8_WAIT_L(0); PG8_BAR; PG8_MMA(0, 0, At, B0); PG8_MMA(0, 1, At, B1); PG8_BAR; PG8_SCHED;
            PG8_LDA(At, 1, 1); PG8_STAGE(PG8_SB(1, 0), b3, voffB); PG8_STAGE(PG8_SB(1, 1), b3 + hstep, voffB); PG8_STAGE(PG8_SA(1, 0), a3, voffA);
            PG8_WAIT_V(8); PG8_WAIT_L(0); PG8_BAR; PG8_MMA(1, 0, At, B0); PG8_MMA(1, 1, At, B1); PG8_BAR; PG8_SCHED;
            } else {
            PG8_LDB(B0, 0, 0); PG8_SCHED; PG8_LDA(At, 0, 0); PG8_STAGE(PG8_SA(1, 1), a1 + hstep, voffA);
            PG8_WAIT_L(8); PG8_BAR; PG8_WAIT_L(0); PG8_MMA(0, 0, At, B0); PG8_BAR; PG8_SCHED;
            PG8_LDB(B1, 0, 1); PG8_STAGE(PG8_SB(0, 0), b2, voffB);
            PG8_BAR; PG8_WAIT_L(0); PG8_MMA(0, 1, At, B1); PG8_BAR;
            PG8_LDA(At, 0, 1); PG8_STAGE(PG8_SA(0, 0), a2, voffA);
            PG8_BAR; PG8_WAIT_L(0); PG8_MMA(1, 0, At, B0); PG8_BAR; PG8_SCHED;
            PG8_STAGE(PG8_SB(0, 1), b2 + hstep, voffB);
            PG8_WAIT_V(6); PG8_BAR; PG8_MMA(1, 1, At, B1); PG8_BAR;
            PG8_LDB(B0, 1, 0); PG8_SCHED; PG8_LDA(At, 1, 0); PG8_STAGE(PG8_SA(0, 1), a2 + hstep, voffA);
            PG8_WAIT_L(8); PG8_BAR; PG8_WAIT_L(0); PG8_MMA(0, 0, At, B0); PG8_BAR; PG8_SCHED;
            PG8_LDB(B1, 1, 1); PG8_STAGE(PG8_SB(1, 0), b3, voffB);
            PG8_BAR; PG8_WAIT_L(0); PG8_MMA(0, 1, At, B1); PG8_BAR;
            PG8_LDA(At, 1, 1); PG8_STAGE(PG8_SA(1, 0), a3, voffA);
            PG8_BAR; PG8_WAIT_L(0); PG8_MMA(1, 0, At, B0); PG8_BAR; PG8_SCHED;
            PG8_STAGE(PG8_SB(1, 1), b3 + hstep, voffB);
            PG8_WAIT_V(6); PG8_BAR; PG8_MMA(1, 1, At, B1); PG8_BAR;
            }
        }
        if constexpr (ALIGN_EPI) { if (wr == 0) PG8_BAR; }
        if constexpr (!Epi::AFTER_DRAIN) { E(acc, cur, wr, wc, fr, fq); S.done(cur); }
        if (!has_next) break;
#pragma unroll
        for (int a = 0; a < 2; ++a)
#pragma unroll
            for (int b = 0; b < 2; ++b)
#pragma unroll
                for (int m = 0; m < 4; ++m)
#pragma unroll
                    for (int n = 0; n < 2; ++n) acc[a][b][m][n] = (f32x4){0.f, 0.f, 0.f, 0.f};
        cur = nxt; cA = nA; cB = nB; ++ui;
        if constexpr (ALIGN_EPI) { if (wr == 1) PG8_BAR; }
    }
    PG8_WAIT_V(0);
    if constexpr (!ALIGN_EPI) { if (wr == 0) PG8_BAR; }
    PG8_BAR;
    if constexpr (Epi::AFTER_DRAIN) { E.fused(acc, cur, wr, wc, fr, fq, lds, wid, lane); S.done(cur); }
#undef PG8_SA
#undef PG8_SB
#undef PG8_STAGE
#undef PG8_LDA
#undef PG8_LDB
#undef PG8_MMA
#undef PG8_WAIT_V
#undef PG8_WAIT_L
#undef PG8_BAR
#undef PG8_SCHED
}
}

#define GAS __attribute__((address_space(1)))
#define LAS __attribute__((address_space(3)))
typedef unsigned short bf16;
typedef float f32x4 __attribute__((ext_vector_type(4)));
typedef float f32x16 __attribute__((ext_vector_type(16)));
typedef short bf16x8 __attribute__((ext_vector_type(8)));
typedef short s16x4 __attribute__((ext_vector_type(4)));
typedef unsigned u32x4 __attribute__((ext_vector_type(4)));
typedef unsigned u32x2 __attribute__((ext_vector_type(2)));

constexpr int DM = 1024, NB = 8, SEQ = 2048, DEPTH = 2, DB = 32, DS = 4, PAST = 8192;
constexpr int MP = NB * SEQ, MS = DB * DS, MR = MP + MS, MPAD = 16640;
constexpr int DFF = 2816, NGU = 2 * DFF, NIN = 5376, NAS = 768;
constexpr int C_Q = 0, C_K = 768, C_V = 1536, C_U = 2304, C_VS = 2816, C_GA = 3328, C_GB = 4352;
constexpr float EPS = 1e-6f;
constexpr float LOG2E = 1.4426950408889634f;
constexpr float QSCALE = 0.125f * LOG2E;
constexpr int NWAVES = 8, NTHR = 512;
constexpr int LDS_BYTES = 147456;

constexpr size_t O_YP = 0, O_YS = 16777216, O_KP0 = 16908288, O_KP1 = 17956864, O_KP2 = 22151168,
                 O_KS0 = 38928384, O_KS1 = 39059456, O_KS2 = 39190528, O_GV = 39321600, O_TOTAL = 39452672;

constexpr size_t MiB = 1u << 20;
constexpr size_t WS_SS = 0;
constexpr size_t WS_W = 1 * MiB;
constexpr size_t WL_GU1 = 0, WL_DN1 = WL_GU1 + (size_t)NGU * DM * 2, WL_IN = WL_DN1 + (size_t)DM * DFF * 2, WL_PA = WL_IN + (size_t)NIN * DM * 2,
                 WL_PS = WL_PA + (size_t)DM * 256 * 2, WL_WO = WL_PS + (size_t)DM * 512 * 2, WL_GU2 = WL_WO + (size_t)DM * DM * 2,
                 WL_DN2 = WL_GU2 + (size_t)NGU * DM * 2, WL_TRIL = WL_DN2 + (size_t)DM * DFF * 2, WL_END = WL_TRIL + 4 * 128 * 128 * 2;
constexpr size_t WL_STRIDE = 48 * MiB;
static_assert(WL_END <= WL_STRIDE, "weights per layer");
constexpr size_t WS_X = WS_W + 2 * WL_STRIDE;
constexpr size_t WS_XB = WS_X + (size_t)MPAD * DM * 4;
constexpr size_t WS_Z = WS_XB + (size_t)MPAD * DM * 2;
constexpr size_t WS_ATT = WS_Z + (size_t)MPAD * NIN * 2;
constexpr size_t WS_SP = WS_ATT + (size_t)MPAD * 256 * 2;
constexpr size_t WS_MIX = WS_SP + (size_t)MPAD * 512 * 2;
constexpr size_t WS_KC = WS_MIX + (size_t)MPAD * DM * 2;
constexpr size_t WS_VC = WS_KC + (size_t)NB * 12 * SEQ * 64 * 2;
constexpr size_t WS_END = WS_VC + (size_t)NB * 12 * SEQ * 64 * 2;

struct Args { const float* in[22]; float* out; unsigned char* ws; int ph_lo, ph_hi; };

__device__ __forceinline__ unsigned f2bf(float f) { unsigned u = __builtin_bit_cast(unsigned, f); return (u + 0x7fffu + ((u >> 16) & 1u)) >> 16; }
__device__ __forceinline__ unsigned pk2(float lo, float hi) { return pg8::cvt_pk_bf16(lo, hi); }
__device__ __forceinline__ float bflo(unsigned w) { return __builtin_bit_cast(float, w << 16); }
__device__ __forceinline__ float bfhi(unsigned w) { return __builtin_bit_cast(float, w & 0xffff0000u); }
__device__ __forceinline__ float fexp2(float x) { return __builtin_amdgcn_exp2f(x); }
__device__ __forceinline__ float frcp(float x) { return __builtin_amdgcn_rcpf(x); }
__device__ __forceinline__ float sigmoidf_(float x) { return frcp(1.0f + fexp2(-LOG2E * x)); }
__device__ __forceinline__ float gelu_tanh(float x) {
    const float t = x * (1.0f + 0.044715f * x * x) * (2.0f * 0.7978845608028654f);
    return x * frcp(1.0f + fexp2(-LOG2E * t));
}
__device__ __forceinline__ float wave_sum(float v) {
#pragma unroll
    for (int o = 1; o < 64; o <<= 1) v += __shfl_xor(v, o);
    return v;
}
__device__ __forceinline__ float wave_max(float v) {
#pragma unroll
    for (int o = 1; o < 64; o <<= 1) v = fmaxf(v, __shfl_xor(v, o));
    return v;
}

#define XB_TMO      128
#define XB_XCNT(j)  (256  + 64 * (j))
#define XB_XSUB(j)  (1280 + 64 * (j))
#define XB_XGEN(j)  (2304 + 64 * (j))
#define XB_TOP      3328
#define XB_TOPGEN   3392
#define XCD_BAR_WORDS 3456
#define XB_SPIN_CAP (1u << 18)

__device__ __forceinline__ unsigned xb_ld(unsigned* p)              { return __hip_atomic_load(p, __ATOMIC_RELAXED, __HIP_MEMORY_SCOPE_AGENT); }
__device__ __forceinline__ unsigned xb_add(unsigned* p, unsigned v) { return __hip_atomic_fetch_add(p, v, __ATOMIC_RELAXED, __HIP_MEMORY_SCOPE_AGENT); }
__device__ __forceinline__ unsigned xb_xcc_id() { return (unsigned)__builtin_amdgcn_s_getreg((3 << 11) | 20) & 0xFu; }
#define XB_SPIN(cond, bar) do { unsigned _sp = 0; while (cond) { __builtin_amdgcn_s_sleep(1); \
    if ((++_sp & 255u) == 0u) { if (xb_ld(&(bar)[XB_TMO])) break; if (_sp > XB_SPIN_CAP) { atomicAdd(&(bar)[XB_TMO], 1u); break; } } } } while (0)

struct XcdBarrier {
    unsigned* bar; unsigned x;
    volatile LAS unsigned* st;
};

__device__ __forceinline__ XcdBarrier xcd_barrier_post(unsigned* bar, volatile LAS unsigned* st) {
    XcdBarrier b; b.bar = bar; b.x = xb_xcc_id(); b.st = st;
    if (threadIdx.x == 0) (void)xb_add(&bar[XB_XCNT(b.x)], 1u);
    return b;
}
__device__ __forceinline__ void xcd_barrier_complete(unsigned* bar, unsigned x, unsigned& nloc, unsigned& nx) {
    const unsigned G = gridDim.x * gridDim.y * gridDim.z;
    unsigned sum, cnt, mine, sp = 0u;
    for (;;) {
        sum = 0u; cnt = 0u; mine = 0u;
#pragma unroll
        for (unsigned j = 0; j < 16; ++j) { const unsigned c = xb_ld(&bar[XB_XCNT(j)]); sum += c; cnt += (c > 0u) ? 1u : 0u; mine = (j == x) ? c : mine; }
        if (sum == G) break;
        __builtin_amdgcn_s_sleep(1);
        if ((++sp & 255u) == 0u) { if (xb_ld(&bar[XB_TMO])) break; if (sp > XB_SPIN_CAP) { atomicAdd(&bar[XB_TMO], 1u); break; } }
    }
    nloc = mine > 0u ? mine : 1u; nx = cnt > 0u ? cnt : 1u;
}

__device__ __forceinline__ void xcd_barrier(const XcdBarrier& b) {
    asm volatile("s_waitcnt vmcnt(0)" ::: "memory");
    __syncthreads();
    if (threadIdx.x == 0) {
        unsigned* bar = b.bar;
        __builtin_amdgcn_s_waitcnt(0);
        unsigned nloc = b.st[0], nx = b.st[1];
        if (nloc == 0u) { xcd_barrier_complete(bar, b.x, nloc, nx); b.st[0] = nloc; b.st[1] = nx; }
        const unsigned old = xb_add(&bar[XB_XSUB(b.x)], 1u);
        const unsigned gen = old / nloc;
        if (old + 1u == (gen + 1u) * nloc) {
            __builtin_amdgcn_fence(__ATOMIC_RELEASE, "agent");
            asm volatile("s_waitcnt vmcnt(0)" ::: "memory");
            const unsigned og = xb_add(&bar[XB_TOP], 1u);
            const unsigned tg = og / nx;
            if (og + 1u == (tg + 1u) * nx) xb_add(&bar[XB_TOPGEN], 1u);
            else XB_SPIN(xb_ld(&bar[XB_TOPGEN]) == tg, bar);
            __builtin_amdgcn_fence(__ATOMIC_ACQUIRE, "agent");
            xb_add(&bar[XB_XGEN(b.x)], 1u);
            asm volatile("s_waitcnt vmcnt(0)" ::: "memory");
        } else {
            XB_SPIN(xb_ld(&bar[XB_XGEN(b.x)]) == gen, bar);
            __builtin_amdgcn_fence(__ATOMIC_ACQUIRE, "agent");
            asm volatile("s_waitcnt vmcnt(0)" ::: "memory");
        }
    }
    __syncthreads();
}

constexpr size_t WS_CTL0 = 768 * 1024, WS_CTL_BYTES = 32 * 1024;
constexpr size_t WS_BAR = 768 * 1024;
constexpr size_t WS_PCNT = 768 * 1024 + 16 * 1024;
static_assert(XCD_BAR_WORDS * 4 <= 16 * 1024 && WS_PCNT + 64 * 256 <= WS_CTL0 + WS_CTL_BYTES, "control words inside the memset region");
constexpr int LDS_MISC = 147456 - 64;

struct EpiGU {
    static constexpr bool PERM = true, AFTER_DRAIN = false;
    bf16* H; const float* ss;
    __device__ __forceinline__ void operator()(const f32x4 (&acc)[2][2][4][2], const pg8::Unit& u, int wr, int wc, int fr, int fq) const {
        const int row0 = u.pm * 256 + wr * 64 + fr, col0 = u.pn * 128 + wc * 32 + 8 * fq;
#pragma unroll
        for (int ai = 0; ai < 2; ++ai)
#pragma unroll
            for (int m = 0; m < 4; ++m) {
                const int row = row0 + ai * 128 + m * 16;
                const float r = rsqrtf(ss[row] * (1.0f / DM) + EPS);
                unsigned w[4];
#pragma unroll
                for (int n = 0; n < 2; ++n) {
                    float hv[4];
#pragma unroll
                    for (int e = 0; e < 4; ++e) { const float g = acc[ai][0][m][n][e] * r, up = acc[ai][1][m][n][e] * r; hv[e] = g * sigmoidf_(g) * up; }
                    w[2 * n] = pk2(hv[0], hv[1]); w[2 * n + 1] = pk2(hv[2], hv[3]);
                }
                *(u32x4*)(H + (size_t)row * DFF + col0) = (u32x4){w[0], w[1], w[2], w[3]};
            }
    }
};
template <bool F32IN> struct EpiResT {
    static constexpr bool PERM = true, AFTER_DRAIN = false;
    const float* Xin; bf16* XB; float* ssn; float alpha;
    __device__ __forceinline__ void operator()(const f32x4 (&acc)[2][2][4][2], const pg8::Unit& u, int wr, int wc, int fr, int fq) const {
        const int row0 = u.pm * 256 + wr * 64 + fr, col0 = u.pn * 256 + wc * 32 + 8 * fq;
        if constexpr (!F32IN) {
            u32x4 xw[2][4][2];
#pragma unroll
            for (int ai = 0; ai < 2; ++ai)
#pragma unroll
                for (int m = 0; m < 4; ++m)
#pragma unroll
                    for (int bj = 0; bj < 2; ++bj) xw[ai][m][bj] = *(const u32x4*)(XB + (size_t)(row0 + ai * 128 + m * 16) * DM + col0 + bj * 128);
#pragma unroll
            for (int ai = 0; ai < 2; ++ai)
#pragma unroll
                for (int m = 0; m < 4; ++m) {
                    const int row = row0 + ai * 128 + m * 16;
                    float s = 0.f;
#pragma unroll
                    for (int bj = 0; bj < 2; ++bj) {
                        const u32x4 w = xw[ai][m][bj];
                        const f32x4 x0 = (f32x4){bflo(w.x), bfhi(w.x), bflo(w.y), bfhi(w.y)} + acc[ai][bj][m][0] * alpha, x1 = (f32x4){bflo(w.z), bfhi(w.z), bflo(w.w), bfhi(w.w)} + acc[ai][bj][m][1] * alpha;
                        *(u32x4*)(XB + (size_t)row * DM + col0 + bj * 128) = (u32x4){pk2(x0[0], x0[1]), pk2(x0[2], x0[3]), pk2(x1[0], x1[1]), pk2(x1[2], x1[3])};
                        s += ((x0[0] * x0[0] + x0[1] * x0[1]) + (x0[2] * x0[2] + x0[3] * x0[3])) + ((x1[0] * x1[0] + x1[1] * x1[1]) + (x1[2] * x1[2] + x1[3] * x1[3]));
                    }
                    s += __shfl_xor(s, 16); s += __shfl_xor(s, 32);
                    if (fq == 0) unsafeAtomicAdd(ssn + row, s);
                }
        } else {
#pragma unroll
        for (int ai = 0; ai < 2; ++ai) {
            f32x4 xin[4][2][2];
#pragma unroll
            for (int m = 0; m < 4; ++m)
#pragma unroll
                for (int bj = 0; bj < 2; ++bj) {
                    const size_t off = (size_t)(row0 + ai * 128 + m * 16) * DM + col0 + bj * 128;
                    xin[m][bj][0] = *(const f32x4*)(Xin + off); xin[m][bj][1] = *(const f32x4*)(Xin + off + 4);
                }
#pragma unroll
            for (int m = 0; m < 4; ++m) {
                const int row = row0 + ai * 128 + m * 16;
                float s = 0.f;
#pragma unroll
                for (int bj = 0; bj < 2; ++bj) {
                    const size_t off = (size_t)row * DM + col0 + bj * 128;
                    const f32x4 x0 = xin[m][bj][0] + acc[ai][bj][m][0] * alpha, x1 = xin[m][bj][1] + acc[ai][bj][m][1] * alpha;
                    *(u32x4*)(XB + off) = (u32x4){pk2(x0[0], x0[1]), pk2(x0[2], x0[3]), pk2(x1[0], x1[1]), pk2(x1[2], x1[3])};
                    s += ((x0[0] * x0[0] + x0[1] * x0[1]) + (x0[2] * x0[2] + x0[3] * x0[3])) + ((x1[0] * x1[0] + x1[1] * x1[1]) + (x1[2] * x1[2] + x1[3] * x1[3]));
                }
                s += __shfl_xor(s, 16); s += __shfl_xor(s, 32);
                if (fq == 0) unsafeAtomicAdd(ssn + row, s);
            }
        }
        }
    }
};
struct EpiResFinal {
    static constexpr bool PERM = true, AFTER_DRAIN = false;
    const bf16* Xin; float* Y; float* ssn; unsigned* pcnt; const float* gain; float alpha;
    __device__ __forceinline__ void operator()(const f32x4 (&acc)[2][2][4][2], const pg8::Unit& u, int wr, int wc, int fr, int fq) const {
        const int row0 = u.pm * 256 + wr * 64 + fr, col0 = u.pn * 256 + wc * 32 + 8 * fq;
#pragma unroll
        for (int ai = 0; ai < 2; ++ai) {
            u32x4 xw[4][2];
#pragma unroll
            for (int m = 0; m < 4; ++m)
#pragma unroll
                for (int bj = 0; bj < 2; ++bj) xw[m][bj] = *(const u32x4*)(Xin + (size_t)(row0 + ai * 128 + m * 16) * DM + col0 + bj * 128);
#pragma unroll
            for (int m = 0; m < 4; ++m) {
                float s = 0.f;
#pragma unroll
                for (int bj = 0; bj < 2; ++bj) {
                    const u32x4 w = xw[m][bj];
                    const f32x4 x0 = (f32x4){bflo(w.x), bfhi(w.x), bflo(w.y), bfhi(w.y)} + acc[ai][bj][m][0] * alpha, x1 = (f32x4){bflo(w.z), bfhi(w.z), bflo(w.w), bfhi(w.w)} + acc[ai][bj][m][1] * alpha;
                    s += ((x0[0] * x0[0] + x0[1] * x0[1]) + (x0[2] * x0[2] + x0[3] * x0[3])) + ((x1[0] * x1[0] + x1[1] * x1[1]) + (x1[2] * x1[2] + x1[3] * x1[3]));
                }
                s += __shfl_xor(s, 16); s += __shfl_xor(s, 32);
                if (fq == 0) unsafeAtomicAdd(ssn + row0 + ai * 128 + m * 16, s);
            }
        }
        asm volatile("s_waitcnt vmcnt(0)" ::: "memory");
        unsigned* cnt = pcnt + 64 * u.pm;
        if ((threadIdx.x & 63) == 0) __hip_atomic_fetch_add(cnt, 1u, __ATOMIC_RELAXED, __HIP_MEMORY_SCOPE_AGENT);
        { unsigned sp = 0; while ((unsigned)__builtin_amdgcn_readfirstlane(__hip_atomic_load(cnt, __ATOMIC_RELAXED, __HIP_MEMORY_SCOPE_AGENT)) < 32u && ++sp < (1u << 20)) __builtin_amdgcn_s_sleep(2); }
        asm volatile("" ::: "memory");
        f32x4 gv[2][2];
#pragma unroll
        for (int bj = 0; bj < 2; ++bj)
#pragma unroll
            for (int n = 0; n < 2; ++n) gv[bj][n] = *(const f32x4*)(gain + col0 + bj * 128 + 4 * n);
#pragma unroll
        for (int ai = 0; ai < 2; ++ai) {
            u32x4 xw[4][2]; float rr[4];
#pragma unroll
            for (int m = 0; m < 4; ++m) {
                const int row = row0 + ai * 128 + m * 16;
                rr[m] = rsqrtf(__hip_atomic_load(ssn + row, __ATOMIC_RELAXED, __HIP_MEMORY_SCOPE_AGENT) * (1.0f / DM) + EPS);
#pragma unroll
                for (int bj = 0; bj < 2; ++bj) xw[m][bj] = *(const u32x4*)(Xin + (size_t)row * DM + col0 + bj * 128);
            }
#pragma unroll
            for (int m = 0; m < 4; ++m)
#pragma unroll
                for (int bj = 0; bj < 2; ++bj) {
                    const int row = row0 + ai * 128 + m * 16;
                    const u32x4 w = xw[m][bj];
                    const f32x4 x0 = (f32x4){bflo(w.x), bfhi(w.x), bflo(w.y), bfhi(w.y)} + acc[ai][bj][m][0] * alpha, x1 = (f32x4){bflo(w.z), bfhi(w.z), bflo(w.w), bfhi(w.w)} + acc[ai][bj][m][1] * alpha;
                    float* yp = Y + (size_t)row * DM + col0 + bj * 128;
                    *(f32x4*)yp = x0 * rr[m] * gv[bj][0]; *(f32x4*)(yp + 4) = x1 * rr[m] * gv[bj][1];
                }
        }
    }
};
struct EpiIn {
    static constexpr bool PERM = true, AFTER_DRAIN = false;
    bf16* Z; const float* ss; float* ssv; float* out; int layer; bf16* KC; bf16* VC;
    __device__ __forceinline__ void operator()(const f32x4 (&acc)[2][2][4][2], const pg8::Unit& u, int wr, int wc, int fr, int fq) const {
        const int pn = u.pn;
        const int row0 = u.pm * 256 + wr * 64 + fr, cc0 = wc * 32 + 8 * fq;
        const int type = pn < 3 ? 0 : pn < 9 ? 1 : pn < 11 ? 2 : pn < 13 ? 3 : 4;
        const int g = (pn - 3) % 3, kvsel = (pn - 3) / 3;
        const int keep = 128 << (2 * g);
        const size_t okp = g == 0 ? O_KP0 : g == 1 ? O_KP1 : O_KP2;
        const size_t oks = g == 0 ? O_KS0 : g == 1 ? O_KS1 : O_KS2;
        float rr[2][4];
#pragma unroll
        for (int ai = 0; ai < 2; ++ai)
#pragma unroll
            for (int m = 0; m < 4; ++m) rr[ai][m] = ss[row0 + ai * 128 + m * 16];
#pragma unroll
        for (int ai = 0; ai < 2; ++ai)
#pragma unroll
            for (int m = 0; m < 4; ++m) {
                const int row = row0 + ai * 128 + m * 16;
                const float r = rsqrtf(rr[ai][m] * (1.0f / DM) + EPS);
                float sv = 0.f;
#pragma unroll
                for (int bj = 0; bj < 2; ++bj) {
                    f32x4 v0 = acc[ai][bj][m][0] * r, v1 = acc[ai][bj][m][1] * r;
                    const int cc = bj * 128 + cc0;
                    if (type == 0) { v0 = v0 * QSCALE; v1 = v1 * QSCALE; }
                    else if (type == 1) {
                        if (row < MP) {
                            const int b = row >> 11, t = row & 2047, trow = t - (SEQ - keep);
                            if (trow >= 0) { float* o = out + okp + ((size_t)((layer * NB + b) * keep + trow) * 2 + kvsel) * 256 + cc; *(f32x4*)o = v0; *(f32x4*)(o + 4) = v1; }
                        } else if (row < MR) {
                            float* o = out + oks + ((size_t)(layer * MS + (row - MP)) * 2 + kvsel) * 256 + cc; *(f32x4*)o = v0; *(f32x4*)(o + 4) = v1;
                        }
                    } else if (type == 2 || type == 3) {
#pragma unroll
                        for (int e = 0; e < 4; ++e) { v0[e] = gelu_tanh(v0[e]); v1[e] = gelu_tanh(v1[e]); }
                        if (type == 3) sv += (v0[0] * v0[0] + v0[1] * v0[1]) + (v0[2] * v0[2] + v0[3] * v0[3]) + (v1[0] * v1[0] + v1[1] * v1[1]) + (v1[2] * v1[2] + v1[3] * v1[3]);
                    } else {
#pragma unroll
                        for (int e = 0; e < 4; ++e) { v0[e] = sigmoidf_(v0[e]); v1[e] = sigmoidf_(v1[e]); }
                    }
                    const u32x4 pk = (u32x4){pk2(v0[0], v0[1]), pk2(v0[2], v0[3]), pk2(v1[0], v1[1]), pk2(v1[2], v1[3])};
                    if (type == 1 && row < MP) {
                        const int b = row >> 11, t = row & 2047, posp = (t & ((1 << (2 * g)) - 1)) * (SEQ >> (2 * g)) + (t >> (2 * g));
                        *(u32x4*)((kvsel ? VC : KC) + ((size_t)((b * 3 + g) * 4 + (cc >> 6)) * SEQ + posp) * 64 + (cc & 63)) = pk;
                    } else *(u32x4*)(Z + (size_t)row * NIN + pn * 256 + cc) = pk;
                }
                if (type == 3) { sv += __shfl_xor(sv, 16); sv += __shfl_xor(sv, 32); if (fq == 0) unsafeAtomicAdd(ssv + row, sv); }
            }
    }
};
template <int PASS> struct EpiProj {
    static constexpr bool PERM = true, AFTER_DRAIN = false;
    bf16* MIX; const bf16* Z;
    __device__ __forceinline__ void operator()(const f32x4 (&acc)[2][2][4][2], const pg8::Unit& u, int wr, int wc, int fr, int fq) const {
        const int row0 = u.pm * 256 + wr * 64 + fr, col0 = u.pn * 256 + wc * 32 + 8 * fq;
        u32x4 gall[2][4][2];
        if (PASS == 0) {
#pragma unroll
            for (int ai = 0; ai < 2; ++ai)
#pragma unroll
                for (int m = 0; m < 4; ++m)
#pragma unroll
                    for (int bj = 0; bj < 2; ++bj) gall[ai][m][bj] = *(const u32x4*)(Z + (size_t)(row0 + ai * 128 + m * 16) * NIN + C_GA + col0 + bj * 128);
        }
#pragma unroll
        for (int ai = 0; ai < 2; ++ai) {
            u32x4 gw[4][2], pw[4][2];
#pragma unroll
            for (int m = 0; m < 4; ++m)
#pragma unroll
                for (int bj = 0; bj < 2; ++bj) {
                    const size_t row = (size_t)(row0 + ai * 128 + m * 16);
                    if (PASS == 0) gw[m][bj] = gall[ai][m][bj];
                    else { gw[m][bj] = *(const u32x4*)(Z + row * NIN + C_GB + col0 + bj * 128); pw[m][bj] = *(const u32x4*)(MIX + row * DM + col0 + bj * 128); }
                }
#pragma unroll
            for (int m = 0; m < 4; ++m)
#pragma unroll
                for (int bj = 0; bj < 2; ++bj) {
                    const size_t row = (size_t)(row0 + ai * 128 + m * 16);
                    const u32x4 g = gw[m][bj];
                    const f32x4 a0 = acc[ai][bj][m][0], a1 = acc[ai][bj][m][1];
                    float o[8];
                    o[0] = bflo(g[0]) * a0[0]; o[1] = bfhi(g[0]) * a0[1]; o[2] = bflo(g[1]) * a0[2]; o[3] = bfhi(g[1]) * a0[3];
                    o[4] = bflo(g[2]) * a1[0]; o[5] = bfhi(g[2]) * a1[1]; o[6] = bflo(g[3]) * a1[2]; o[7] = bfhi(g[3]) * a1[3];
                    if (PASS == 1) {
                        const u32x4 p = pw[m][bj];
                        o[0] += bflo(p[0]); o[1] += bfhi(p[0]); o[2] += bflo(p[1]); o[3] += bfhi(p[1]);
                        o[4] += bflo(p[2]); o[5] += bfhi(p[2]); o[6] += bflo(p[3]); o[7] += bfhi(p[3]);
                    }
                    *(u32x4*)(MIX + row * DM + col0 + bj * 128) = (u32x4){pk2(o[0], o[1]), pk2(o[2], o[3]), pk2(o[4], o[5]), pk2(o[6], o[7])};
                }
            asm volatile("" ::: "memory");
        }
    }
};

__device__ __forceinline__ void transpose_item(const float* W, int K, int N, bf16* WT, int k0, int n0, int dst_row0, const float* gain, LAS float* scr, int lane) {
    f32x4 v[16];
    const int lr = lane >> 4, lc = (lane & 15) * 4;
    const float* src = W + (size_t)(k0 + lr) * N + n0 + lc;
#pragma unroll
    for (int i = 0; i < 16; ++i) v[i] = *(const f32x4*)(src + (size_t)(4 * i) * N);
    const int c = lane & 7;
    f32x4 g0 = (f32x4){1.f, 1.f, 1.f, 1.f}, g1 = g0;
    if (gain) { g0 = *(const f32x4*)(gain + k0 + 8 * c); g1 = *(const f32x4*)(gain + k0 + 8 * c + 4); }
#pragma unroll
    for (int i = 0; i < 16; ++i) { LAS float* d = scr + (4 * i + lr) * 65 + lc; d[0] = v[i][0]; d[1] = v[i][1]; d[2] = v[i][2]; d[3] = v[i][3]; }
    asm volatile("s_waitcnt lgkmcnt(0)" ::: "memory");
#pragma unroll
    for (int j = 0; j < 8; ++j) { const int n = (lane >> 3) + 8 * j; const LAS float* sp = scr + (8 * c) * 65 + n;
        u32x4 o; o.x = pk2(sp[0 * 65] * g0[0], sp[1 * 65] * g0[1]); o.y = pk2(sp[2 * 65] * g0[2], sp[3 * 65] * g0[3]); o.z = pk2(sp[4 * 65] * g1[0], sp[5 * 65] * g1[1]); o.w = pk2(sp[6 * 65] * g1[2], sp[7 * 65] * g1[3]);
        *(u32x4*)(WT + (size_t)(dst_row0 + n) * K + k0 + 8 * c) = o; }
    asm volatile("s_waitcnt lgkmcnt(0)" ::: "memory");
}
__device__ __forceinline__ void conv_matrix_item(const float* W, int K, int N, bf16* WT, int item, int mode  , const float* gain, LAS float* scr, int lane) {
    const int nblk = N / 64, kb = item / nblk, nb = item % nblk, n0 = 64 * nb;
    const int dst = mode == 0 ? n0 : ((n0 >> 7) * 256 + (n0 & 127) + (mode == 2 ? 128 : 0));
    transpose_item(W, K, N, WT, 64 * kb, n0, dst, gain, scr, lane);
}

constexpr int I_G = (DM / 64) * (DFF / 64), I_D = (DFF / 64) * (DM / 64), I_IN = (DM / 64) * (NIN / 64), I_PA = (256 / 64) * (DM / 64), I_PS = (512 / 64) * (DM / 64), I_WO = (DM / 64) * (DM / 64);
constexpr int I_LAYER = 6 * I_G + I_IN + I_PA + I_PS + I_WO;
constexpr int I_FFN1 = 3 * I_G, I_MIXW = I_IN + I_PA + I_PS + I_WO, I_FFN2_0 = I_FFN1 + I_MIXW;
static_assert(I_G == I_D, "items");
__device__ __forceinline__ void conv_layer_item(const Args& a, int l, int r, LAS float* scr, int lane) {
    unsigned char* wl = a.ws + WS_W + (size_t)l * WL_STRIDE;
    if (r < I_G) { conv_matrix_item(a.in[6] + (size_t)l * DM * DFF, DM, DFF, (bf16*)(wl + WL_GU1), r, 1, a.in[5] + l * DM, scr, lane); return; } r -= I_G;
    if (r < I_G) { conv_matrix_item(a.in[7] + (size_t)l * DM * DFF, DM, DFF, (bf16*)(wl + WL_GU1), r, 2, a.in[5] + l * DM, scr, lane); return; } r -= I_G;
    if (r < I_D) { conv_matrix_item(a.in[8] + (size_t)l * DFF * DM, DFF, DM, (bf16*)(wl + WL_DN1), r, 0, nullptr, scr, lane); return; } r -= I_D;
    if (r < I_IN) { conv_matrix_item(a.in[10] + (size_t)l * DM * NIN, DM, NIN, (bf16*)(wl + WL_IN), r, 0, a.in[9] + l * DM, scr, lane); return; } r -= I_IN;
    if (r < I_PA) { conv_matrix_item(a.in[14] + (size_t)l * 256 * DM, 256, DM, (bf16*)(wl + WL_PA), r, 0, nullptr, scr, lane); return; } r -= I_PA;
    if (r < I_PS) { conv_matrix_item(a.in[15] + (size_t)l * 512 * DM, 512, DM, (bf16*)(wl + WL_PS), r, 0, nullptr, scr, lane); return; } r -= I_PS;
    if (r < I_WO) { conv_matrix_item(a.in[16] + (size_t)l * DM * DM, DM, DM, (bf16*)(wl + WL_WO), r, 0, nullptr, scr, lane); return; } r -= I_WO;
    if (r < I_G) { conv_matrix_item(a.in[18] + (size_t)l * DM * DFF, DM, DFF, (bf16*)(wl + WL_GU2), r, 1, a.in[17] + l * DM, scr, lane); return; } r -= I_G;
    if (r < I_G) { conv_matrix_item(a.in[19] + (size_t)l * DM * DFF, DM, DFF, (bf16*)(wl + WL_GU2), r, 2, a.in[17] + l * DM, scr, lane); return; } r -= I_G;
    conv_matrix_item(a.in[20] + (size_t)l * DFF * DM, DFF, DM, (bf16*)(wl + WL_DN2), r, 0, nullptr, scr, lane);
}
__device__ __forceinline__ void conv_items(const Args& a, LAS unsigned char* lds, int lo, int hi, int widx, int nw, int wave, int lane) {
    LAS float* scr = (LAS float*)(lds + wave * 16640);
    for (int it = lo + widx; it < hi; it += nw) conv_layer_item(a, it / I_LAYER, it % I_LAYER, scr, lane);
}
__device__ __forceinline__ void conv_in_idle_tail(const Args& a, LAS unsigned char* lds, int nwg_tiles, int lo, int hi, int wave, int lane) {
    const int G = gridDim.x, wg = blockIdx.x;
    const int first_idle = nwg_tiles % G;
    if (wg < first_idle) return;
    conv_items(a, lds, lo, hi, (wg - first_idle) * NWAVES + wave, (G - first_idle) * NWAVES, wave, lane);
}

__device__ __forceinline__ void phase_prologue(const Args& a, LAS unsigned char* lds, int gw, int NGW, int lane, int wave) {
    unsigned char* ws = a.ws;
    { float* ss = (float*)(ws + WS_SS); const int gt = gw * 64 + lane, NT = NGW * 64;
      for (int i = MPAD + gt; i < 9 * MPAD; i += NT) ss[i] = 0.f; }
    conv_items(a, lds, 0, 2 * I_LAYER, gw, NGW, wave, lane);
    { const int gt = gw * 64 + lane, NT = NGW * 64;
      for (int i = gt; i < 2 * 4 * 128 * 128; i += NT) { const int l = i >> 16, rem = i & 65535, t = (rem >> 7) & 127, s = rem & 127;
          const float v = s <= t ? a.in[12][i] : 0.f; ((bf16*)(ws + WS_W + (size_t)l * WL_STRIDE + WL_TRIL))[rem] = (bf16)f2bf(v); } }
    bf16* XB = (bf16*)(ws + WS_XB); float* ss0 = (float*)(ws + WS_SS);
    for (int m = gw; m < MPAD; m += NGW) {
        f32x4 v[4]; float s = 0.f;
        if (m < MR) { const float* src = m < MP ? a.in[0] + (size_t)m * DM : a.in[1] + (size_t)(m - MP) * DM;
#pragma unroll
            for (int j = 0; j < 4; ++j) { v[j] = *(const f32x4*)(src + 4 * lane + 256 * j); s += (v[j][0] * v[j][0] + v[j][1] * v[j][1]) + (v[j][2] * v[j][2] + v[j][3] * v[j][3]); }
        } else {
#pragma unroll
            for (int j = 0; j < 4; ++j) v[j] = (f32x4){0.f, 0.f, 0.f, 0.f};
        }
        s = wave_sum(s);
#pragma unroll
        for (int j = 0; j < 4; ++j) *(u32x2*)(XB + (size_t)m * DM + 4 * lane + 256 * j) = (u32x2){pk2(v[j][0], v[j][1]), pk2(v[j][2], v[j][3])};
        if (lane == 0) ss0[m] = s;
    }
}

#define MFMA32(a, b, c) __builtin_amdgcn_mfma_f32_32x32x16_bf16((a), (b), (c), 0, 0, 0)
typedef short v4i16_t __attribute__((ext_vector_type(4)));
__device__ __forceinline__ s16x4 tr_read(const LAS unsigned char* p) { return __builtin_bit_cast(s16x4, __builtin_amdgcn_ds_read_tr16_b64_v4i16((LAS v4i16_t*)p)); }
__device__ __forceinline__ float alibi_slope2(int hidx) { return fexp2(-8.0f * (float)(hidx + 1) / 12.0f) * LOG2E; }

constexpr int VP = 192;
constexpr int KP = 144;
constexpr int ATT_WAVE_LDS = 32 * VP + 32 * KP;

__device__ __forceinline__ void attn_prompt_task(const bf16* Z, const bf16* KC, const bf16* VC, bf16* AS, int task, LAS unsigned char* vl, int lane) {
    const int rho = task & 15, c5 = (task >> 4) & 3, islot = (task >> 6) & 3, b = task >> 8;
    const int ql = lane & 31, h = lane >> 5;
    const int t0 = 512 * c5 + rho, tq = t0 + 16 * ql, tmax = t0 + 496;
    const size_t rowq = (size_t)b * SEQ + tq;
    f32x16 o0, o1;
#pragma unroll
    for (int i = 0; i < 16; ++i) { o0[i] = 0.f; o1[i] = 0.f; }
    float mrun = -1e30f, lrun = 0.f;
    const int i16 = lane & 15, tq_ = i16 >> 2, tp = i16 & 3, blk = (lane >> 4) & 1;
    const int traddr = (4 * h + tq_) * VP + 32 * blk + 8 * tp;
    const int crow_ = lane >> 3, cchk = lane & 7;
    LAS unsigned char* kl = vl + 32 * VP;
    for (int g = 0; g < 3; ++g) {
        const int dil = 1 << (2 * g), W = 128 << (2 * g), nblk = g == 0 ? 20 : g == 1 ? 8 : 5;
        const float slope2 = alibi_slope2(g * 4 + islot);
        const int qcol = C_Q + g * 256 + islot * 64 + 8 * h;
        const int rres = tmax & (dil - 1), nper = SEQ >> (2 * g);
        const bf16* kbase = KC + ((size_t)((b * 3 + g) * 4 + islot) * SEQ + rres * nper) * 64;
        const bf16* vbase = VC + ((size_t)((b * 3 + g) * 4 + islot) * SEQ + rres * nper) * 64;
        bf16x8 qf[4];
#pragma unroll
        for (int st = 0; st < 4; ++st) qf[st] = *(const bf16x8*)(Z + rowq * NIN + qcol + 16 * st);
        const int lim = tq < W ? tq : W;
        u32x4 krn[4], vrn[4];
        {   const int jb0 = (tmax - dil * 31 - rres) >> (2 * g);
#pragma unroll
            for (int i = 0; i < 4; ++i) { int rj = jb0 + crow_ + 8 * i; rj = rj < 0 ? 0 : rj; krn[i] = *(const u32x4*)(kbase + (size_t)rj * 64 + 8 * cchk); vrn[i] = *(const u32x4*)(vbase + (size_t)rj * 64 + 8 * cchk); }
        }
        for (int c = 0; c < nblk; ++c) {
            const int kb = tmax - dil * (32 * c + 31);
            if (kb + 31 * dil < 0) break;
            u32x4 kr[4], vr[4];
#pragma unroll
            for (int i = 0; i < 4; ++i) { kr[i] = krn[i]; vr[i] = vrn[i]; }
            {
                const int jb1 = ((kb - rres) >> (2 * g)) - 32;
#pragma unroll
                for (int i = 0; i < 4; ++i) { int rj = jb1 + crow_ + 8 * i; rj = rj < 0 ? 0 : rj; krn[i] = *(const u32x4*)(kbase + (size_t)rj * 64 + 8 * cchk); vrn[i] = *(const u32x4*)(vbase + (size_t)rj * 64 + 8 * cchk); }
            }
#pragma unroll
            for (int i = 0; i < 4; ++i) { *(LAS u32x4*)(kl + (crow_ + 8 * i) * KP + 16 * cchk) = kr[i]; *(LAS u32x4*)(vl + (crow_ + 8 * i) * VP + 16 * cchk) = vr[i]; }
            asm volatile("s_waitcnt lgkmcnt(0)" ::: "memory");
            bf16x8 kf[4];
#pragma unroll
            for (int st = 0; st < 4; ++st) kf[st] = *(const LAS bf16x8*)(kl + ql * KP + 32 * st + 16 * h);
            const int dq = tq - kb - dil * 4 * h;
            const float binit = -slope2 * (float)dq, sd = slope2 * (float)dil;
            f32x16 sacc;
#pragma unroll
            for (int i = 0; i < 16; ++i) {
                const int ci = (i & 3) + 8 * (i >> 2);
                const int dist = dq - dil * ci;
                sacc[i] = ((unsigned)dist <= (unsigned)lim) ? fmaf(sd, (float)ci, binit) : -INFINITY;
            }
#pragma unroll
            for (int st = 0; st < 4; ++st) sacc = MFMA32(kf[st], qf[st], sacc);
            float mloc = fmaxf(fmaxf(fmaxf(sacc[0], sacc[1]), fmaxf(sacc[2], sacc[3])), fmaxf(fmaxf(sacc[4], sacc[5]), fmaxf(sacc[6], sacc[7])));
            mloc = fmaxf(mloc, fmaxf(fmaxf(fmaxf(sacc[8], sacc[9]), fmaxf(sacc[10], sacc[11])), fmaxf(fmaxf(sacc[12], sacc[13]), fmaxf(sacc[14], sacc[15]))));
            { auto sw = __builtin_amdgcn_permlane32_swap(__builtin_bit_cast(unsigned, mloc), __builtin_bit_cast(unsigned, mloc), false, false);
              mloc = fmaxf(__builtin_bit_cast(float, (unsigned)sw[0]), __builtin_bit_cast(float, (unsigned)sw[1])); }
            const float mnew = fmaxf(mrun, mloc);
            const float alpha = fexp2(mrun - mnew);
            mrun = mnew;
            float ps0 = 0.f, ps1 = 0.f;
#pragma unroll
            for (int i = 0; i < 16; i += 2) { const float p0 = fexp2(sacc[i] - mnew), p1 = fexp2(sacc[i + 1] - mnew); sacc[i] = p0; sacc[i + 1] = p1; ps0 += p0; ps1 += p1; }
            lrun = lrun * alpha + (ps0 + ps1);
            if (__builtin_amdgcn_ballot_w64(alpha != 1.0f) != 0ull) {
#pragma unroll
                for (int i = 0; i < 16; ++i) { o0[i] *= alpha; o1[i] *= alpha; }
            }
            bf16x8 pb[2];
#pragma unroll
            for (int s = 0; s < 2; ++s) {
                u32x4 w; w.x = pk2(sacc[8 * s + 0], sacc[8 * s + 1]); w.y = pk2(sacc[8 * s + 2], sacc[8 * s + 3]); w.z = pk2(sacc[8 * s + 4], sacc[8 * s + 5]); w.w = pk2(sacc[8 * s + 6], sacc[8 * s + 7]);
                pb[s] = __builtin_bit_cast(bf16x8, w);
            }
            asm volatile("s_waitcnt lgkmcnt(0)" ::: "memory");
#pragma unroll
            for (int s = 0; s < 2; ++s) {
                const s16x4 a00 = tr_read(vl + traddr + (16 * s) * VP), a01 = tr_read(vl + traddr + (16 * s + 8) * VP);
                const s16x4 a10 = tr_read(vl + traddr + (16 * s) * VP + 64), a11 = tr_read(vl + traddr + (16 * s + 8) * VP + 64);
                const bf16x8 va0 = __builtin_shufflevector(a00, a01, 0, 1, 2, 3, 4, 5, 6, 7), va1 = __builtin_shufflevector(a10, a11, 0, 1, 2, 3, 4, 5, 6, 7);
                o0 = MFMA32(va0, pb[s], o0);
                o1 = MFMA32(va1, pb[s], o1);
            }
            asm volatile("s_waitcnt lgkmcnt(0)" ::: "memory");
        }
    }
    const float ltot = lrun + __shfl_xor(lrun, 32);
    const float inv = 1.0f / ltot;
    bf16* op = AS + rowq * 256 + islot * 64 + 4 * h;
#pragma unroll
    for (int g4 = 0; g4 < 4; ++g4) {
        *(u32x2*)(op + 8 * g4) = (u32x2){pk2(o0[4 * g4] * inv, o0[4 * g4 + 1] * inv), pk2(o0[4 * g4 + 2] * inv, o0[4 * g4 + 3] * inv)};
        *(u32x2*)(op + 32 + 8 * g4) = (u32x2){pk2(o1[4 * g4] * inv, o1[4 * g4 + 1] * inv), pk2(o1[4 * g4 + 2] * inv, o1[4 * g4 + 3] * inv)};
    }
}

__device__ __forceinline__ void attn_sample_unit(const Args& a, const bf16* Z, int layer, int task, int g, LAS float* sc, LAS float* part, int lane) {
    const int j = task & 3, islot = (task >> 2) & 3, b = task >> 4;
    const size_t rowq = (size_t)MP + b * DS + j;
    const int sub = lane >> 4, l16 = lane & 15;
    const int dil = 1 << (2 * g), W = 128 << (2 * g);
    const float slope2 = alibi_slope2(g * 4 + islot);
    const float* cache = (g == 0 ? a.in[2] : g == 1 ? a.in[3] : a.in[4]) + ((size_t)(layer * DB + b) * W) * 512 + islot * 64 + 4 * l16;
    f32x4 q4;
    { const u32x2 qw = *(const u32x2*)(Z + rowq * NIN + C_Q + g * 256 + islot * 64 + 4 * l16); q4 = (f32x4){bflo(qw.x), bfhi(qw.x), bflo(qw.y), bfhi(qw.y)}; }
    const int nnew = g == 0 ? j + 1 : 1;
    float sn = -INFINITY; f32x4 vn4;
    {   const int i = sub < nnew ? sub : 0;
        const bf16* rp = Z + ((size_t)MP + b * DS + (j - i * dil)) * NIN + g * 256 + islot * 64 + 4 * l16;
        const u32x2 kw = *(const u32x2*)(rp + C_K), vw = *(const u32x2*)(rp + C_V);
        float d = q4[0] * bflo(kw.x) + q4[1] * bfhi(kw.x) + q4[2] * bflo(kw.y) + q4[3] * bfhi(kw.y);
        d += __shfl_xor(d, 1); d += __shfl_xor(d, 2); d += __shfl_xor(d, 4); d += __shfl_xor(d, 8);
        if (sub < nnew) sn = d - slope2 * (float)(i * dil);
        vn4 = (f32x4){bflo(vw.x), bfhi(vw.x), bflo(vw.y), bfhi(vw.y)};
    }
    float gmax = sn;
    const size_t stride = (size_t)4 * dil * 512;
    const float* kp = cache + (size_t)(W + j - (nnew + sub) * dil) * 512;
#pragma unroll 1
    for (int hb = 0; hb < 2; ++hb) {
        f32x4 kw[16];
#pragma unroll
        for (int it = 0; it < 16; ++it) kw[it] = *(const f32x4*)(kp - (size_t)(16 * hb + it) * stride);
#pragma unroll
        for (int it = 0; it < 16; ++it) {
            const int i = nnew + 4 * (16 * hb + it) + sub;
            float d = (q4[0] * kw[it][0] + q4[1] * kw[it][1]) + (q4[2] * kw[it][2] + q4[3] * kw[it][3]);
            d += __shfl_xor(d, 1); d += __shfl_xor(d, 2); d += __shfl_xor(d, 4); d += __shfl_xor(d, 8);
            const float sv = i <= 128 ? d - slope2 * (float)(i * dil) : -INFINITY;
            sc[(16 * hb + it) * 64 + lane] = sv; gmax = fmaxf(gmax, sv);
        }
    }
    gmax = fmaxf(gmax, __shfl_xor(gmax, 16)); gmax = fmaxf(gmax, __shfl_xor(gmax, 32));
    float lrun; f32x4 o4;
    { const float p = fexp2(sn - gmax); lrun = p; o4 = vn4 * p; }
    asm volatile("s_waitcnt lgkmcnt(0)" ::: "memory");
#pragma unroll 1
    for (int hb = 0; hb < 2; ++hb) {
        f32x4 vw[16];
#pragma unroll
        for (int it = 0; it < 16; ++it) vw[it] = *(const f32x4*)(kp + 256 - (size_t)(16 * hb + it) * stride);
#pragma unroll
        for (int it = 0; it < 16; ++it) { const float p = fexp2(sc[(16 * hb + it) * 64 + lane] - gmax); lrun += p; o4 = o4 + vw[it] * p; }
    }
    lrun += __shfl_xor(lrun, 16); lrun += __shfl_xor(lrun, 32);
#pragma unroll
    for (int e = 0; e < 4; ++e) { float v = o4[e]; v += __shfl_xor(v, 16); v += __shfl_xor(v, 32); o4[e] = v; }
    if (sub == 0) *(LAS f32x4*)(part + 4 + 4 * l16) = o4;
    if (lane == 0) { part[0] = gmax; part[1] = lrun; }
    asm volatile("s_waitcnt lgkmcnt(0)" ::: "memory");
}
__device__ __forceinline__ void attn_sample_combine(bf16* AS, int task, const LAS float* part3, int d) {
    const int j = task & 3, islot = (task >> 2) & 3, b = task >> 4;
    const size_t rowq = (size_t)MP + b * DS + j;
    const float m0 = part3[0], m1 = part3[72], m2 = part3[144];
    const float M = fmaxf(m0, fmaxf(m1, m2));
    const float w0 = fexp2(m0 - M), w1 = fexp2(m1 - M), w2 = fexp2(m2 - M);
    const float L = w0 * part3[1] + w1 * part3[73] + w2 * part3[145];
    const float o = w0 * part3[4 + d] + w1 * part3[76 + d] + w2 * part3[148 + d];
    AS[rowq * 256 + islot * 64 + d] = (bf16)f2bf(o / L);
}

constexpr int GP = 320;
__device__ __forceinline__ void gmlp_prompt_unit(const Args& a, const bf16* Z, bf16* AS, const float* ssv, int layer, int unit, LAS unsigned char* lds, int tid, int wave, int lane) {
    const int gg = unit & 3, n = unit >> 2, m0 = n * 128;
    const bf16* Wt = (const bf16*)(a.ws + WS_W + (size_t)layer * WL_STRIDE + WL_TRIL) + gg * 128 * 128;
    const float* gain = a.in[11] + layer * 512 + gg * 128;
    const float* bias = a.in[13] + (layer * 4 + gg) * 128;
    __syncthreads();
    {
        const int row = tid >> 2, qt = tid & 3;
        const float rv = rsqrtf(ssv[m0 + row] * (1.0f / 512.0f) + EPS);
        const bf16* src = Z + (size_t)(m0 + row) * NIN + C_VS + gg * 128 + 32 * qt;
#pragma unroll
        for (int jj = 0; jj < 4; ++jj) {
            const u32x4 w = *(const u32x4*)(src + 8 * jj);
            const f32x4 g0 = *(const f32x4*)(gain + 32 * qt + 8 * jj), g1 = *(const f32x4*)(gain + 32 * qt + 8 * jj + 4);
            u32x4 o;
            o.x = pk2(bflo(w.x) * rv * g0[0], bfhi(w.x) * rv * g0[1]); o.y = pk2(bflo(w.y) * rv * g0[2], bfhi(w.y) * rv * g0[3]);
            o.z = pk2(bflo(w.z) * rv * g1[0], bfhi(w.z) * rv * g1[1]); o.w = pk2(bflo(w.w) * rv * g1[2], bfhi(w.w) * rv * g1[3]);
            *(LAS u32x4*)(lds + row * GP + (32 * qt + 8 * jj) * 2) = o;
        }
    }
    __syncthreads();
    const int ct = wave & 3, tl = lane & 31, h = lane >> 5;
    const int i16 = lane & 15, tq_ = i16 >> 2, tp = i16 & 3, blk = (lane >> 4) & 1;
    const int traddr = (8 * h + tq_) * GP + (32 * ct + 16 * blk + 4 * tp) * 2;
#pragma unroll
    for (int half = 0; half < 2; ++half) {
        const int tt = half == 0 ? (wave >> 2) : 3 - (wave >> 2);
        f32x16 acc;
#pragma unroll
        for (int i = 0; i < 16; ++i) acc[i] = 0.f;
        const bf16* wrow = Wt + (size_t)(32 * tt + tl) * 128 + 8 * h;
        const int nks = 2 * (tt + 1);
        bf16x8 wb[8];
#pragma unroll
        for (int ks = 0; ks < 8; ++ks) if (ks < nks) wb[ks] = *(const bf16x8*)(wrow + 16 * ks);
#pragma unroll
        for (int ks = 0; ks < 8; ++ks) if (ks < nks) {
            const s16x4 a0 = tr_read(lds + traddr + (16 * ks) * GP), a1 = tr_read(lds + traddr + (16 * ks + 4) * GP);
            const bf16x8 va = __builtin_shufflevector(a0, a1, 0, 1, 2, 3, 4, 5, 6, 7);
            acc = MFMA32(va, wb[ks], acc);
        }
        const int trow = 32 * tt + tl;
        const float bs = bias[trow];
        const size_t row = (size_t)m0 + trow;
#pragma unroll
        for (int i4 = 0; i4 < 4; ++i4) {
            const int c = 32 * ct + 8 * i4 + 4 * h;
            const u32x2 uw = *(const u32x2*)(Z + row * NIN + C_U + gg * 128 + c);
            const float z0 = (acc[4 * i4] + bs) * bflo(uw.x), z1 = (acc[4 * i4 + 1] + bs) * bfhi(uw.x), z2 = (acc[4 * i4 + 2] + bs) * bflo(uw.y), z3 = (acc[4 * i4 + 3] + bs) * bfhi(uw.y);
            *(u32x2*)(AS + row * 512 + gg * 128 + c) = (u32x2){pk2(z0, z1), pk2(z2, z3)};
        }
    }
}
__device__ __forceinline__ void gmlp_prompt_pair(const Args& a, const bf16* Z, bf16* AS, const float* ssv, int layer, int u0, LAS unsigned char* lds, int tid, int wave, int lane) {
    const int gg = u0 & 3;
    const bf16* Wt = (const bf16*)(a.ws + WS_W + (size_t)layer * WL_STRIDE + WL_TRIL) + gg * 128 * 128;
    const float* gain = a.in[11] + layer * 512 + gg * 128;
    const float* bias = a.in[13] + (layer * 4 + gg) * 128;
    const int row = tid >> 2, qt = tid & 3;
    const int ct = wave & 3, tl = lane & 31, h = lane >> 5;
    u32x4 vt[2][4]; float sv[2];
#pragma unroll
    for (int uu = 0; uu < 2; ++uu) {
        const int m0 = ((u0 + 256 * uu) >> 2) * 128;
        sv[uu] = ssv[m0 + row];
        const bf16* src = Z + (size_t)(m0 + row) * NIN + C_VS + gg * 128 + 32 * qt;
#pragma unroll
        for (int jj = 0; jj < 4; ++jj) vt[uu][jj] = *(const u32x4*)(src + 8 * jj);
    }
    f32x4 g0[4], g1[4];
#pragma unroll
    for (int jj = 0; jj < 4; ++jj) { g0[jj] = *(const f32x4*)(gain + 32 * qt + 8 * jj); g1[jj] = *(const f32x4*)(gain + 32 * qt + 8 * jj + 4); }
    const int ttA = wave >> 2, ttB = 3 - (wave >> 2);
    bf16x8 wbA[4], wbB[8];
    {   const bf16* wrA = Wt + (size_t)(32 * ttA + tl) * 128 + 8 * h; const bf16* wrB = Wt + (size_t)(32 * ttB + tl) * 128 + 8 * h;
#pragma unroll
        for (int ks = 0; ks < 4; ++ks) if (ks < 2 * (ttA + 1)) wbA[ks] = *(const bf16x8*)(wrA + 16 * ks);
#pragma unroll
        for (int ks = 0; ks < 8; ++ks) if (ks < 2 * (ttB + 1)) wbB[ks] = *(const bf16x8*)(wrB + 16 * ks);
    }
    u32x2 uw[2][2][4]; float bs[2];
    bs[0] = bias[32 * ttA + tl]; bs[1] = bias[32 * ttB + tl];
#pragma unroll
    for (int uu = 0; uu < 2; ++uu)
#pragma unroll
        for (int hf = 0; hf < 2; ++hf) {
            const size_t r = (size_t)((u0 + 256 * uu) >> 2) * 128 + 32 * (hf == 0 ? ttA : ttB) + tl;
#pragma unroll
            for (int i4 = 0; i4 < 4; ++i4) uw[uu][hf][i4] = *(const u32x2*)(Z + r * NIN + C_U + gg * 128 + 32 * ct + 8 * i4 + 4 * h);
        }
    __syncthreads();
#pragma unroll
    for (int uu = 0; uu < 2; ++uu) {
        const float rv = rsqrtf(sv[uu] * (1.0f / 512.0f) + EPS);
#pragma unroll
        for (int jj = 0; jj < 4; ++jj) {
            const u32x4 w = vt[uu][jj];
            u32x4 o;
            o.x = pk2(bflo(w.x) * rv * g0[jj][0], bfhi(w.x) * rv * g0[jj][1]); o.y = pk2(bflo(w.y) * rv * g0[jj][2], bfhi(w.y) * rv * g0[jj][3]);
            o.z = pk2(bflo(w.z) * rv * g1[jj][0], bfhi(w.z) * rv * g1[jj][1]); o.w = pk2(bflo(w.w) * rv * g1[jj][2], bfhi(w.w) * rv * g1[jj][3]);
            *(LAS u32x4*)(lds + uu * (128 * GP) + row * GP + (32 * qt + 8 * jj) * 2) = o;
        }
    }
    __syncthreads();
    const int i16 = lane & 15, tq_ = i16 >> 2, tp = i16 & 3, blk = (lane >> 4) & 1;
    const int traddr = (8 * h + tq_) * GP + (32 * ct + 16 * blk + 4 * tp) * 2;
#pragma unroll
    for (int uu = 0; uu < 2; ++uu)
#pragma unroll
        for (int hf = 0; hf < 2; ++hf) {
            const int tt = hf == 0 ? ttA : ttB;
            const LAS unsigned char* tile = lds + uu * (128 * GP);
            f32x16 acc;
#pragma unroll
            for (int i = 0; i < 16; ++i) acc[i] = 0.f;
            if (hf == 0) {
#pragma unroll
                for (int ks = 0; ks < 4; ++ks) if (ks < 2 * (tt + 1)) {
                    const s16x4 a0 = tr_read(tile + traddr + (16 * ks) * GP), a1 = tr_read(tile + traddr + (16 * ks + 4) * GP);
                    acc = MFMA32(__builtin_shufflevector(a0, a1, 0, 1, 2, 3, 4, 5, 6, 7), wbA[ks], acc);
                }
            } else {
#pragma unroll
                for (int ks = 0; ks < 8; ++ks) if (ks < 2 * (tt + 1)) {
                    const s16x4 a0 = tr_read(tile + traddr + (16 * ks) * GP), a1 = tr_read(tile + traddr + (16 * ks + 4) * GP);
                    acc = MFMA32(__builtin_shufflevector(a0, a1, 0, 1, 2, 3, 4, 5, 6, 7), wbB[ks], acc);
                }
            }
            const size_t r = (size_t)((u0 + 256 * uu) >> 2) * 128 + 32 * tt + tl;
            const float b_ = bs[hf];
#pragma unroll
            for (int i4 = 0; i4 < 4; ++i4) {
                const int c = 32 * ct + 8 * i4 + 4 * h;
                const u32x2 uv = uw[uu][hf][i4];
                const float z0 = (acc[4 * i4] + b_) * bflo(uv.x), z1 = (acc[4 * i4 + 1] + b_) * bfhi(uv.x), z2 = (acc[4 * i4 + 2] + b_) * bflo(uv.y), z3 = (acc[4 * i4 + 3] + b_) * bfhi(uv.y);
                *(u32x2*)(AS + r * 512 + gg * 128 + c) = (u32x2){pk2(z0, z1), pk2(z2, z3)};
            }
        }
}
__device__ __forceinline__ void gmlp_sample_unit(const Args& a, const bf16* Z, bf16* AS, const float* ssv, int layer, int b, int tid) {
    const int c = tid, gg = c >> 7;
    const float gain = a.in[11][layer * 512 + c];
    const float* Wf = a.in[12] + (size_t)(layer * 4 + gg) * 128 * 128;
    const float* bias = a.in[13] + (layer * 4 + gg) * 128;
    float vn[4];
#pragma unroll
    for (int j = 0; j < 4; ++j) {
        const size_t row = (size_t)MP + b * DS + j;
        const float rv = rsqrtf(ssv[row] * (1.0f / 512.0f) + EPS);
        vn[j] = bflo((unsigned)Z[row * NIN + C_VS + c]) * rv * gain;
        a.out[O_GV + ((size_t)(layer * DB + b) * DS + j) * 512 + c] = vn[j];
    }
#pragma unroll
    for (int j = 0; j < 4; ++j) {
        const size_t row = (size_t)MP + b * DS + j;
        float z = bias[j];
#pragma unroll
        for (int s = 0; s < 4; ++s) if (s <= j) z = fmaf(Wf[j * 128 + s], vn[s], z);
        const float uu = bflo((unsigned)Z[row * NIN + C_U + c]);
        AS[row * 512 + c] = (bf16)f2bf(uu * z);
    }
}

__device__ __forceinline__ void phase_mixer(const Args& a, int layer, LAS unsigned char* lds, int tid, int wave, int lane) {
    const bf16* Z = (const bf16*)(a.ws + WS_Z); bf16* AT = (bf16*)(a.ws + WS_ATT); bf16* SP = (bf16*)(a.ws + WS_SP);
    const float* ssv = (const float*)(a.ws + WS_SS) + (7 + layer) * MPAD;
    const int G = gridDim.x, wg = blockIdx.x;
#ifndef MX_MASK
#define MX_MASK 15
#endif
    if (MX_MASK & 1) for (int tk = wg * NWAVES + wave; tk < 2048; tk += G * NWAVES) { const int task = (G == 256) ? ((wg & 7) * 256 + (wg >> 3) * NWAVES + wave) : tk; attn_prompt_task(Z, (const bf16*)(a.ws + WS_KC), (const bf16*)(a.ws + WS_VC), AT, task, lds + wave * ATT_WAVE_LDS, lane); }
    if (MX_MASK & 2) for (int base = wg * 2; base < 512; base += G * 2) {
        LAS float* part = (LAS float*)(lds + 98304);
        if (wave < 6) attn_sample_unit(a, Z, layer, base + wave / 3, wave % 3, (LAS float*)(lds + wave * ATT_WAVE_LDS), part + wave * 72, lane);
        __syncthreads();
        if (tid < 128) attn_sample_combine(AT, base + (tid >> 6), part + (tid >> 6) * 216, tid & 63);
    }
    if (MX_MASK & 4) { if (G == 256) gmlp_prompt_pair(a, Z, SP, ssv, layer, wg, lds, tid, wave, lane); else for (int unit = wg; unit < 512; unit += G) gmlp_prompt_unit(a, Z, SP, ssv, layer, unit, lds, tid, wave, lane); }
    if (MX_MASK & 8) for (int b = G - 1 - wg; b < DB; b += G) gmlp_sample_unit(a, Z, SP, ssv, layer, b, tid);
}

#define MFMA16(a, b, c) __builtin_amdgcn_mfma_f32_16x16x32_bf16((a), (b), (c), 0, 0, 0)
__device__ __forceinline__ void skinny_partial(const bf16* A, const bf16* Bt, int K, int r0, int n0, int wave, int lane, f32x4& acc0, f32x4& acc1) {
    const int ksl = K >> 3, nst = ksl >> 5;
    const bf16* ap = A + (size_t)(r0 + (lane & 15)) * K + wave * ksl + 8 * (lane >> 4);
    const bf16* bp0 = Bt + (size_t)(n0 + (lane & 15)) * K + wave * ksl + 8 * (lane >> 4);
    const bf16* bp1 = bp0 + (size_t)16 * K;
#pragma unroll 1
    for (int s0 = 0; s0 < nst; s0 += 6) {
        bf16x8 av[6], b0[6], b1[6];
#pragma unroll
        for (int u = 0; u < 6; ++u) if (s0 + u < nst) { av[u] = *(const bf16x8*)(ap + 32 * (s0 + u)); b0[u] = *(const bf16x8*)(bp0 + 32 * (s0 + u)); b1[u] = *(const bf16x8*)(bp1 + 32 * (s0 + u)); }
#pragma unroll
        for (int u = 0; u < 6; ++u) if (s0 + u < nst) { acc0 = MFMA16(b0[u], av[u], acc0); acc1 = MFMA16(b1[u], av[u], acc1); }
    }
}
template <int MODE> __device__ __forceinline__ void skinny_phase(LAS unsigned char* lds, const bf16* A, const bf16* Bt, int K, const bf16* A2, const bf16* Bt2, int K2,
                                                                  const float* XinS  , bf16* XB, float* ssn, float alpha, bf16* MIX, const bf16* Z, int tid, int wave, int lane) {
    LAS float* red = (LAS float*)lds;
    const int G = gridDim.x;
    for (int piece = blockIdx.x; piece < 256; piece += G) {
        const int rb = piece >> 5, cb = piece & 31, r0 = MP + 16 * rb, n0 = 32 * cb;
        __syncthreads();
        f32x4 a0 = (f32x4){0.f, 0.f, 0.f, 0.f}, a1 = a0;
        skinny_partial(A, Bt, K, r0, n0, wave, lane, a0, a1);
        *(LAS f32x4*)(red + wave * 512 + lane * 8) = a0; *(LAS f32x4*)(red + wave * 512 + lane * 8 + 4) = a1;
        if (MODE == 1) {
            f32x4 c0 = (f32x4){0.f, 0.f, 0.f, 0.f}, c1 = c0;
            skinny_partial(A2, Bt2, K2, r0, n0, wave, lane, c0, c1);
            *(LAS f32x4*)(red + 4096 + wave * 512 + lane * 8) = c0; *(LAS f32x4*)(red + 4096 + wave * 512 + lane * 8 + 4) = c1;
        }
        __syncthreads();
        const int m = tid >> 5, c = tid & 31, e = (((c & 15) >> 2) * 16 + m) * 8 + (c >> 4) * 4 + (c & 3);
        float s1 = 0.f, s2 = 0.f;
#pragma unroll
        for (int w = 0; w < 8; ++w) { s1 += red[w * 512 + e]; if (MODE == 1) s2 += red[4096 + w * 512 + e]; }
        const size_t row = (size_t)r0 + m; const int col = n0 + c;
        if (MODE == 0) {
            const float x = (XinS ? XinS[(size_t)(16 * rb + m) * DM + col] : bflo((unsigned)XB[row * DM + col])) + alpha * s1;
            XB[row * DM + col] = (bf16)f2bf(x);
            float q = x * x;
            q += __shfl_xor(q, 1); q += __shfl_xor(q, 2); q += __shfl_xor(q, 4); q += __shfl_xor(q, 8); q += __shfl_xor(q, 16);
            if (c == 0) unsafeAtomicAdd(ssn + row, q);
        } else {
            const float ga = bflo((unsigned)Z[row * NIN + C_GA + col]), gb = bflo((unsigned)Z[row * NIN + C_GB + col]);
            MIX[row * DM + col] = (bf16)f2bf(ga * s1 + gb * s2);
        }
    }
}

__device__ __forceinline__ void phase_final(const Args& a, int gw, int NGW, int lane) {
    const bf16* XB = (const bf16*)(a.ws + WS_XB); const float* ss = (const float*)(a.ws + WS_SS) + 6 * MPAD; const float* gain = a.in[21];
    const int mlo = ((int)gridDim.x == (MP / 256) * (DM / 256)) ? MP : 0;
    for (int m = mlo + gw; m < MR; m += NGW) {
        const float r = rsqrtf(ss[m] * (1.0f / DM) + EPS);
#pragma unroll
        for (int j = 0; j < 4; ++j) { const u32x2 w = *(const u32x2*)(XB + (size_t)m * DM + 4 * lane + 256 * j); const f32x4 v = (f32x4){bflo(w.x), bfhi(w.x), bflo(w.y), bfhi(w.y)}, g = *(const f32x4*)(gain + 4 * lane + 256 * j);
            *(f32x4*)(a.out + (size_t)m * DM + 4 * lane + 256 * j) = v * r * g; }
    }
}

constexpr int N_PHASES = 18;
#ifndef MK_MASK
#define MK_MASK 0xFFFF
#endif
#ifndef PJ_MASK
#define PJ_MASK 3
#endif
template <int PH> __device__ __forceinline__ void run_phase(const Args& a, LAS unsigned char* lds) {
    int tid_ = threadIdx.x; asm volatile("" : "+v"(tid_));
    const int tid = tid_, lane = tid & 63, wave = __builtin_amdgcn_readfirstlane(tid >> 6);
    const int G = gridDim.x, wg = blockIdx.x;
    const int gw = wg * NWAVES + wave, NGW = G * NWAVES;
    unsigned char* ws = a.ws;
    float* SS = (float*)(ws + WS_SS);
    float* X = (float*)(ws + WS_X); bf16* XB = (bf16*)(ws + WS_XB); bf16* Zb = (bf16*)(ws + WS_Z); bf16* HB = (bf16*)(ws + WS_Z);
    bf16* ATb = (bf16*)(ws + WS_ATT); bf16* SPb = (bf16*)(ws + WS_SP); bf16* MIX = (bf16*)(ws + WS_MIX);
    if constexpr (PH == 0) { if (MK_MASK & 1) phase_prologue(a, lds, gw, NGW, lane, wave); }
    else if constexpr (PH == N_PHASES - 1) { if (MK_MASK & 2) phase_final(a, gw, NGW, lane); }
    else {
        constexpr int layer = (PH - 1) >> 3, sub = (PH - 1) & 7;
        unsigned char* wl = ws + WS_W + (size_t)layer * WL_STRIDE;
        pg8::StaticOrder S;
        if constexpr (sub == 0 || sub == 6) {
            if (MK_MASK & 4) {
            pg8::Gemm g{XB, (const bf16*)(wl + (sub == 0 ? WL_GU1 : WL_GU2)), MPAD, NGU, DM}; S.init(MPAD, NGU, G, wg);
            EpiGU E{HB, SS + (3 * layer + (sub == 0 ? 0 : 2)) * MPAD};
            pg8::gemm_phase<EpiGU, pg8::StaticOrder, true, true>(lds, g, S, E); }
        } else if constexpr (sub == 1 || sub == 7) {
            if (MK_MASK & 8) {
            pg8::Gemm g{HB, (const bf16*)(wl + (sub == 1 ? WL_DN1 : WL_DN2)), MP, DM, DFF}; S.init(MP, DM, G, wg);
            if constexpr (PH == N_PHASES - 2) {
                if (G * 1 == (MP / 256) * (DM / 256)) { EpiResFinal E{XB, a.out, SS + 6 * MPAD, (unsigned*)(ws + WS_PCNT), a.in[21], 0.5f}; pg8::gemm_phase<EpiResFinal, pg8::StaticOrder, true, true>(lds, g, S, E); }
                else { EpiResT<false> E{nullptr, XB, SS + 6 * MPAD, 0.5f}; pg8::gemm_phase<EpiResT<false>, pg8::StaticOrder, true, true>(lds, g, S, E); }
            } else {
            EpiResT<PH == 2> E{a.in[0], XB, SS + (3 * layer + (sub == 1 ? 1 : 3)) * MPAD, 0.5f};
            pg8::gemm_phase<EpiResT<PH == 2>, pg8::StaticOrder, true, true>(lds, g, S, E); }
            skinny_phase<0>(lds, HB, (const bf16*)(wl + (sub == 1 ? WL_DN1 : WL_DN2)), DFF, nullptr, nullptr, 0, PH == 2 ? a.in[1] : nullptr, XB, SS + (3 * layer + (sub == 1 ? 1 : 3)) * MPAD, 0.5f, nullptr, nullptr, tid, wave, lane); }
        } else if constexpr (sub == 2) {
            if (MK_MASK & 16) {
            pg8::Gemm g{XB, (const bf16*)(wl + WL_IN), MPAD, NIN, DM}; S.init(MPAD, NIN, G, wg);
            EpiIn E{Zb, SS + (3 * layer + 1) * MPAD, SS + (7 + layer) * MPAD, a.out, layer, (bf16*)(ws + WS_KC), (bf16*)(ws + WS_VC)};
            pg8::gemm_phase<EpiIn, pg8::StaticOrder, true, true>(lds, g, S, E); }
        } else if constexpr (sub == 3) {
            if (MK_MASK & 32) phase_mixer(a, layer, lds, tid, wave, lane);
        } else if constexpr (sub == 4) {
            if (MK_MASK & 64) {
            S.init(MP, DM, G, wg);
            if (PJ_MASK & 1) { pg8::Gemm g{ATb, (const bf16*)(wl + WL_PA), MP, DM, 256}; EpiProj<0> E{MIX, Zb}; pg8::gemm_phase<EpiProj<0>, pg8::StaticOrder, true, true>(lds, g, S, E); }
            __syncthreads();
            if (PJ_MASK & 2) { pg8::Gemm g{SPb, (const bf16*)(wl + WL_PS), MP, DM, 512}; EpiProj<1> E{MIX, Zb}; pg8::gemm_phase<EpiProj<1>, pg8::StaticOrder, true, true>(lds, g, S, E); }
            skinny_phase<1>(lds, ATb, (const bf16*)(wl + WL_PA), 256, SPb, (const bf16*)(wl + WL_PS), 512, nullptr, nullptr, nullptr, 0.f, MIX, Zb, tid, wave, lane); }
        } else {
            if (MK_MASK & 128) {
            pg8::Gemm g{MIX, (const bf16*)(wl + WL_WO), MP, DM, DM}; S.init(MP, DM, G, wg);
            EpiResT<false> E{nullptr, XB, SS + (3 * layer + 2) * MPAD, 1.0f};
            pg8::gemm_phase<EpiResT<false>, pg8::StaticOrder, true, true>(lds, g, S, E);
            skinny_phase<0>(lds, MIX, (const bf16*)(wl + WL_WO), DM, nullptr, nullptr, 0, nullptr, XB, SS + (3 * layer + 2) * MPAD, 1.0f, nullptr, nullptr, tid, wave, lane); }
        }
    }
}
template <int PH> __device__ __forceinline__ void run_from(const Args& a, LAS unsigned char* lds, int ph_lo, int ph_hi, const XcdBarrier& bar) {
    if constexpr (PH < N_PHASES) {
        if (ph_lo <= PH && PH < ph_hi) {
            if (PH > ph_lo) xcd_barrier(bar);
            run_phase<PH>(a, lds);
#ifndef PROBE_REP
#define PROBE_REP 0
#endif
            { constexpr int sub_ = (PH - 1) & 7; constexpr bool mid_ = PH > 0 && PH < N_PHASES - 1;
              if ((PH == 0 && (PROBE_REP & 1)) || (mid_ && (sub_ == 0 || sub_ == 6) && (PROBE_REP & 4)) || (mid_ && sub_ == 3 && (PROBE_REP & 32)) || (mid_ && sub_ == 4 && (PROBE_REP & 64))) { __syncthreads(); run_phase<PH>(a, lds); } }
        }
        run_from<PH + 1>(a, lds, ph_lo, ph_hi, bar);
    }
}
__global__ void __launch_bounds__(NTHR, 2) mk_fwd(Args a) {
    extern __shared__ __attribute__((aligned(16))) unsigned char lds_raw[];
    LAS unsigned char* lds = (LAS unsigned char*)lds_raw;
    if (a.ph_lo < 0) cg::this_grid().sync();
    if (threadIdx.x < 2) ((volatile LAS unsigned*)(lds + LDS_MISC))[threadIdx.x] = 0u;
    __syncthreads();
    XcdBarrier bar; bar.bar = (unsigned*)(a.ws + WS_BAR); bar.x = 0; bar.st = (volatile LAS unsigned*)(lds + LDS_MISC);
    if (a.ph_hi - a.ph_lo > 1) bar = xcd_barrier_post((unsigned*)(a.ws + WS_BAR), (volatile LAS unsigned*)(lds + LDS_MISC));
    run_from<0>(a, lds, a.ph_lo, a.ph_hi, bar);
}

#ifndef MK_MULTI
#define MK_MULTI 0
#endif
extern "C" void kernel_launch(void* const* d_in, const int* in_sizes, int n_in, void* d_out, int out_size, void* d_ws, size_t ws_size, hipStream_t stream) {
    static int grid = 0;
    if (grid == 0) {
        if (n_in != 22 || (size_t)out_size != O_TOTAL || ws_size < WS_END) { fprintf(stderr, "kernel_launch: unexpected shapes n_in %d out %d ws %zu (need %zu)\n", n_in, out_size, ws_size, (size_t)WS_END); grid = -1; return; }
        int dev = 0, cus = 0, per_cu = 0;
        hipGetDevice(&dev); hipDeviceGetAttribute(&cus, hipDeviceAttributeMultiprocessorCount, dev);
        if (hipFuncSetAttribute((const void*)mk_fwd, hipFuncAttributeMaxDynamicSharedMemorySize, LDS_BYTES) != hipSuccess) { fprintf(stderr, "kernel_launch: hipFuncSetAttribute failed\n"); grid = -1; return; }
        if (hipOccupancyMaxActiveBlocksPerMultiprocessor(&per_cu, (const void*)mk_fwd, NTHR, LDS_BYTES) != hipSuccess || per_cu < 1) { fprintf(stderr, "kernel_launch: occupancy query failed (%d)\n", per_cu); (void)hipGetLastError(); per_cu = 1; }
        grid = cus * 1;
        if (per_cu < 1) grid = -1;
    }
    if (grid < 0) return;
    if (hipMemsetAsync((char*)d_ws + WS_CTL0, 0, WS_CTL_BYTES, stream) != hipSuccess) { fprintf(stderr, "kernel_launch: hipMemsetAsync failed\n"); return; }
    Args a{};
    for (int i = 0; i < 22; ++i) a.in[i] = (const float*)d_in[i];
    a.out = (float*)d_out; a.ws = (unsigned char*)d_ws;
#if MK_MULTI
    for (int ph = 0; ph < N_PHASES; ++ph) { a.ph_lo = ph; a.ph_hi = ph + 1; hipLaunchKernelGGL(mk_fwd, dim3(grid), dim3(NTHR), LDS_BYTES, stream, a); }
#else
    a.ph_lo = 0; a.ph_hi = N_PHASES;
    void* args[] = {&a};
    hipError_t e = hipLaunchCooperativeKernel((const void*)mk_fwd, dim3(grid), dim3(NTHR), args, LDS_BYTES, stream);
    if (e != hipSuccess) fprintf(stderr, "cooperative launch failed: %s (grid %d)\n", hipGetErrorString(e), grid);
#endif
}
```

```cpp
#include <hip/hip_runtime.h>
#include <hip/hip_cooperative_groups.h>
#include <cstdio>
#include <cstdint>
namespace cg = cooperative_groups;
namespace pg8 {
#define PG8_LAS __attribute__((address_space(3)))
typedef unsigned short bf16_t;
typedef short bf16x8 __attribute__((ext_vector_type(8)));
typedef float f32x4 __attribute__((ext_vector_type(4)));
typedef unsigned u32x4 __attribute__((ext_vector_type(4)));
constexpr int BM = 256, BK = 64, HALF = 128, HTB = HALF * BK * 2  , STAGE_BYTES = 8 * HTB, NXCD = 8, WGM = 8;

__host__ __device__ __forceinline__ int lds_byte(int r, int c) { const int st = (r >> 4) * 2 + (c >> 5), rr = r & 15, cc = c & 31, ob = rr * 64 + cc * 2; return st * 1024 + (ob ^ (((ob >> 9) & 1) << 5)); }
__host__ __device__ __forceinline__ void stage_rc(int b, int& R, int& C) { const int st = b / 1024, sb = b % 1024, swz = sb ^ (((sb >> 9) & 1) << 5); R = (st >> 1) * 16 + swz / 64; C = (st & 1) * 32 + (swz % 64) / 2; }
__host__ __device__ __forceinline__ int perm32(int rho) { const int n = rho >> 4, i = rho & 15; return 8 * (i >> 2) + 4 * n + (i & 3); }

struct Unit { int pm, pn; };
struct Gemm { const bf16_t* A; const bf16_t* Bt; int M, N, K; };

struct StaticOrder {
    int nM, nN, nwg, G, c;
    __host__ __device__ void init(int M, int N, int G_, int c_) { nM = M / BM; nN = N / BM; nwg = nM * nN; G = G_; c = c_; }
    __host__ __device__ bool next(int i, Unit& u) const {
        const long L = (long)i * G + c; if (L >= nwg) return false;
        int wgid = (int)L; { const int q = nwg / NXCD, r = nwg % NXCD, xcd = wgid % NXCD, off = wgid / NXCD; wgid = (xcd < r ? xcd * (q + 1) : r * (q + 1) + (xcd - r) * q) + off; }
        const int nig = WGM * nN, gid = wgid / nig, fm = gid * WGM, gsz = (nM - fm) < WGM ? (nM - fm) : WGM;
        u.pm = fm + ((wgid % nig) % gsz); u.pn = (wgid % nig) / gsz; return true;
    }
    __device__ __forceinline__ void a_ready(const Unit&) const {}
    __device__ __forceinline__ void done(const Unit&) const {}
};

__device__ __forceinline__ unsigned cvt_pk_bf16(float lo, float hi) { unsigned r; asm volatile("v_cvt_pk_bf16_f32 %0, %1, %2" : "=v"(r) : "v"(lo), "v"(hi)); return r; }
typedef float f32x2 __attribute__((ext_vector_type(2)));
template <class Epi, class Sched, bool ALIGN_EPI = false, bool SP2 = false>
__device__ __forceinline__ void gemm_phase(PG8_LAS unsigned char* lds, const Gemm g, const Sched& S, const Epi& E) {
    int tid_ = threadIdx.x; asm volatile("" : "+v"(tid_));
    const int tid = tid_, wid = __builtin_amdgcn_readfirstlane(tid >> 6), lane = tid & 63, wr = wid >> 2, wc = wid & 3, fr = lane & 15, fq = lane >> 4;
    int K_ = g.K; asm volatile("" : "+s"(K_));
    const int K = K_, nt = K / BK;
    unsigned voffA[2], voffB[2];
#pragma unroll
    for (int i = 0; i < 2; ++i) { int R, C; stage_rc(tid * 16 + i * 8192, R, C); const int Rb = Epi::PERM ? ((R & ~31) + perm32(R & 31)) : R;
        voffA[i] = (unsigned)(R * K + C) * 2u; voffB[i] = (unsigned)(Rb * K + C) * 2u; }
    const size_t kstep = (size_t)(BK * 2);
    const size_t hstep = (size_t)HALF * K * 2;
    const size_t tstep = 2 * hstep;
    const unsigned ldsw = (unsigned)wid * 1024u;
    const int aoff = lds_byte(wr * 64 + fr, fq * 8), boff = lds_byte(wc * 32 + fr, fq * 8);
#define PG8_SA(b, h) (((b) * 2 + (h)) * HTB)
#define PG8_SB(b, h) ((4 + (b) * 2 + (h)) * HTB)
#define PG8_STAGE(bufoff, gbase, voff) do { _Pragma("unroll") for (int _i = 0; _i < 2; ++_i) \
        __builtin_amdgcn_global_load_lds((const unsigned*)((const char*)(gbase) + (voff)[_i]), (PG8_LAS unsigned*)(lds + (bufoff) + ldsw + _i * 8192), 16, 0, 0); } while (0)
#define PG8_LDA(dst, b, h) do { _Pragma("unroll") for (int m = 0; m < 4; ++m) _Pragma("unroll") for (int k = 0; k < 2; ++k) dst[m][k] = *(const PG8_LAS bf16x8*)(lds + PG8_SA(b, h) + aoff + m * 2048 + k * 1024); } while (0)
#define PG8_LDB(dst, b, h) do { _Pragma("unroll") for (int n = 0; n < 2; ++n) _Pragma("unroll") for (int k = 0; k < 2; ++k) dst[n][k] = *(const PG8_LAS bf16x8*)(lds + PG8_SB(b, h) + boff + n * 2048 + k * 1024); } while (0)
#define PG8_MMA(ai, bj, At, Bt) do { __builtin_amdgcn_s_setprio(1); _Pragma("unroll") for (int m = 0; m < 4; ++m) _Pragma("unroll") for (int n = 0; n < 2; ++n) _Pragma("unroll") for (int k = 0; k < 2; ++k) \
        acc[ai][bj][m][n] = __builtin_amdgcn_mfma_f32_16x16x32_bf16(Bt[n][k], At[m][k], acc[ai][bj][m][n], 0, 0, 0); __builtin_amdgcn_s_setprio(0); } while (0)
#define PG8_WAIT_V(n) asm volatile("s_waitcnt vmcnt(" #n ")" ::: "memory")
#define PG8_WAIT_L(n) asm volatile("s_waitcnt lgkmcnt(" #n ")" ::: "memory")
#define PG8_BAR __builtin_amdgcn_s_barrier()
#define PG8_SCHED __builtin_amdgcn_sched_barrier(0)
    Unit cur, nxt; int ui = 0;
    if (!S.next(0, cur)) return;
    f32x4 acc[2][2][4][2];
#pragma unroll
    for (int a = 0; a < 2; ++a)
#pragma unroll
        for (int b = 0; b < 2; ++b)
#pragma unroll
            for (int m = 0; m < 4; ++m)
#pragma unroll
                for (int n = 0; n < 2; ++n) acc[a][b][m][n] = (f32x4){0.f, 0.f, 0.f, 0.f};
    bf16x8 At[4][2], B0[2][2], B1[2][2];
    const char* cA = (const char*)g.A + (size_t)cur.pm * tstep; const char* cB = (const char*)g.Bt + (size_t)cur.pn * tstep;
    S.a_ready(cur);
    if constexpr (SP2) {
        PG8_STAGE(PG8_SB(0, 0), cB, voffB); PG8_STAGE(PG8_SB(0, 1), cB + hstep, voffB); PG8_STAGE(PG8_SA(0, 0), cA, voffA); PG8_STAGE(PG8_SA(0, 1), cA + hstep, voffA);
        if (wr == 1) PG8_BAR;
        PG8_WAIT_V(2); PG8_BAR;
        PG8_STAGE(PG8_SB(1, 0), cB + kstep, voffB); PG8_STAGE(PG8_SA(1, 0), cA + kstep, voffA); PG8_STAGE(PG8_SB(1, 1), cB + hstep + kstep, voffB);
        PG8_WAIT_V(6); PG8_BAR;
    } else {
        PG8_STAGE(PG8_SB(0, 0), cB, voffB); PG8_STAGE(PG8_SA(0, 0), cA, voffA); PG8_STAGE(PG8_SB(0, 1), cB + hstep, voffB); PG8_STAGE(PG8_SA(0, 1), cA + hstep, voffA);
        if (wr == 1) PG8_BAR;
        PG8_WAIT_V(4); PG8_BAR;
        PG8_STAGE(PG8_SB(1, 0), cB + kstep, voffB); PG8_STAGE(PG8_SA(1, 0), cA + kstep, voffA); PG8_STAGE(PG8_SB(1, 1), cB + hstep + kstep, voffB);
        PG8_WAIT_V(6); PG8_BAR;
    }
    for (;;) {
        const bool has_next = S.next(ui + 1, nxt);
        const char* nA = has_next ? (const char*)g.A + (size_t)nxt.pm * tstep : cA; const char* nB = has_next ? (const char*)g.Bt + (size_t)nxt.pn * tstep : cB;
        for (int t = 0; t < nt; t += 2) {
            const bool last = (t == nt - 2);
            const char* a1 = cA + (size_t)(t + 1) * kstep;
            const char* a2 = last ? nA : cA + (size_t)(t + 2) * kstep; const char* b2 = last ? nB : cB + (size_t)(t + 2) * kstep;
            const char* a3 = a2 + kstep; const char* b3 = b2 + kstep;
            if (last && has_next) S.a_ready(nxt);
            if constexpr (SP2) {
            PG8_LDB(B0, 0, 0); PG8_LDB(B1, 0, 1); PG8_SCHED; PG8_LDA(At, 0, 0); PG8_STAGE(PG8_SA(1, 1), a1 + hstep, voffA);
            PG8_WAIT_V(8); PG8_WAIT_L(0); PG8_BAR; PG8_MMA(0, 0, At, B0); PG8_MMA(0, 1, At, B1); PG8_BAR; PG8_SCHED;
            PG8_LDA(At, 0, 1); PG8_STAGE(PG8_SB(0, 0), b2, voffB); PG8_STAGE(PG8_SB(0, 1), b2 + hstep, voffB); PG8_STAGE(PG8_SA(0, 0), a2, voffA);
            PG8_WAIT_V(8); PG8_WAIT_L(0); PG8_BAR; PG8_MMA(1, 0, At, B0); PG8_MMA(1, 1, At, B1); PG8_BAR; PG8_SCHED;
            PG8_LDB(B0, 1, 0); PG8_LDB(B1, 1, 1); PG8_SCHED; PG8_LDA(At, 1, 0); PG8_STAGE(PG8_SA(0, 1), a2 + hstep, voffA);
            PG8_WAIT_V(8); PG8_WAIT_L(0); PG8_BAR; PG8_MMA(0, 0, At, B0); PG8_MMA(0, 1, At, B1); PG8_BAR; PG8_SCHED;
            PG8_LDA(At, 1, 1); PG8_STAGE(PG8_SB(1, 0), b3, voffB); PG8_STAGE(PG8_SB(1, 1), b3 + hstep, voffB); PG8_STAGE(PG8_SA(1, 0), a3, voffA);
            PG8_WAIT_V(8); PG8_WAIT_L(0); PG8_BAR; PG8_MMA(1, 0, At, B0); PG8_MMA(1, 1, At, B1); PG8_BAR; PG8_SCHED;
            } else {
            PG8_LDB(B0, 0, 0); PG8_SCHED; PG8_LDA(At, 0, 0); PG8_STAGE(PG8_SA(1, 1), a1 + hstep, voffA);
            PG8_WAIT_L(8); PG8_BAR; PG8_WAIT_L(0); PG8_MMA(0, 0, At, B0); PG8_BAR; PG8_SCHED;
            PG8_LDB(B1, 0, 1); PG8_STAGE(PG8_SB(0, 0), b2, voffB);
            PG8_BAR; PG8_WAIT_L(0); PG8_MMA(0, 1, At, B1); PG8_BAR;
            PG8_LDA(At, 0, 1); PG8_STAGE(PG8_SA(0, 0), a2, voffA);
            PG8_BAR; PG8_WAIT_L(0); PG8_MMA(1, 0, At, B0); PG8_BAR; PG8_SCHED;
            PG8_STAGE(PG8_SB(0, 1), b2 + hstep, voffB);
            PG8_WAIT_V(6); PG8_BAR; PG8_MMA(1, 1, At, B1); PG8_BAR;
            PG8_LDB(B0, 1, 0); PG8_SCHED; PG8_LDA(At, 1, 0); PG8_STAGE(PG8_SA(0, 1), a2 + hstep, voffA);
            PG8_WAIT_L(8); PG8_BAR; PG8_WAIT_L(0); PG8_MMA(0, 0, At, B0); PG8_BAR; PG8_SCHED;
            PG8_LDB(B1, 1, 1); PG8_STAGE(PG8_SB(1, 0), b3, voffB);
            PG8_BAR; PG8_WAIT_L(0); PG8_MMA(0, 1, At, B1); PG8_BAR;
            PG8_LDA(At, 1, 1); PG8_STAGE(PG8_SA(1, 0), a3, voffA);
            PG8_BAR; PG8_WAIT_L(0); PG8_MMA(1, 0, At, B0); PG8_BAR; PG8_SCHED;
            PG8_STAGE(PG8_SB(1, 1), b3 + hstep, voffB);
            PG8_WAIT_V(6); PG8_BAR; PG8_MMA(1, 1, At, B1); PG8_BAR;
            }
        }
        if constexpr (ALIGN_EPI) { if (wr == 0) PG8_BAR; }
        if constexpr (!Epi::AFTER_DRAIN) { E(acc, cur, wr, wc, fr, fq); S.done(cur); }
        if (!has_next) break;
#pragma unroll
        for (int a = 0; a < 2; ++a)
#pragma unroll
            for (int b = 0; b < 2; ++b)
#pragma unroll
                for (int m = 0; m < 4; ++m)
#pragma unroll
                    for (int n = 0; n < 2; ++n) acc[a][b][m][n] = (f32x4){0.f, 0.f, 0.f, 0.f};
        cur = nxt; cA = nA; cB = nB; ++ui;
        if constexpr (ALIGN_EPI) { if (wr == 1) PG8_BAR; }
    }
    PG8_WAIT_V(0);
    if constexpr (!ALIGN_EPI) { if (wr == 0) PG8_BAR; }
    PG8_BAR;
    if constexpr (Epi::AFTER_DRAIN) { E.fused(acc, cur, wr, wc, fr, fq, lds, wid, lane); S.done(cur); }
#undef PG8_SA
#undef PG8_SB
#undef PG8_STAGE
#undef PG8_LDA
#undef PG8_LDB
#undef PG8_MMA
#undef PG8_WAIT_V
#undef PG8_WAIT_L
#undef PG8_BAR
#undef PG8_SCHED
}
}

#define GAS __attribute__((address_space(1)))
#define LAS __attribute__((address_space(3)))
typedef unsigned short bf16;
typedef float f32x4 __attribute__((ext_vector_type(4)));
typedef float f32x16 __attribute__((ext_vector_type(16)));
typedef short bf16x8 __attribute__((ext_vector_type(8)));
typedef short s16x4 __attribute__((ext_vector_type(4)));
typedef unsigned u32x4 __attribute__((ext_vector_type(4)));
typedef unsigned u32x2 __attribute__((ext_vector_type(2)));

constexpr int DM = 1024, NB = 8, SEQ = 2048, DEPTH = 2, DB = 32, DS = 4, PAST = 8192;
constexpr int MP = NB * SEQ, MS = DB * DS, MR = MP + MS, MPAD = 16640;
constexpr int DFF = 2816, NGU = 2 * DFF, NIN = 5376, NAS = 768;
constexpr int C_Q = 0, C_K = 768, C_V = 1536, C_U = 2304, C_VS = 2816, C_GA = 3328, C_GB = 4352;
constexpr float EPS = 1e-6f;
constexpr float LOG2E = 1.4426950408889634f;
constexpr float QSCALE = 0.125f * LOG2E;
constexpr int NWAVES = 8, NTHR = 512;
constexpr int LDS_BYTES = 147456;

constexpr size_t O_YP = 0, O_YS = 16777216, O_KP0 = 16908288, O_KP1 = 17956864, O_KP2 = 22151168,
                 O_KS0 = 38928384, O_KS1 = 39059456, O_KS2 = 39190528, O_GV = 39321600, O_TOTAL = 39452672;

constexpr size_t MiB = 1u << 20;
constexpr size_t WS_SS = 0;
constexpr size_t WS_W = 1 * MiB;
constexpr size_t WL_GU1 = 0, WL_DN1 = WL_GU1 + (size_t)NGU * DM * 2, WL_IN = WL_DN1 + (size_t)DM * DFF * 2, WL_PA = WL_IN + (size_t)NIN * DM * 2,
                 WL_PS = WL_PA + (size_t)DM * 256 * 2, WL_WO = WL_PS + (size_t)DM * 512 * 2, WL_GU2 = WL_WO + (size_t)DM * DM * 2,
                 WL_DN2 = WL_GU2 + (size_t)NGU * DM * 2, WL_TRIL = WL_DN2 + (size_t)DM * DFF * 2, WL_END = WL_TRIL + 4 * 128 * 128 * 2;
constexpr size_t WL_STRIDE = 48 * MiB;
static_assert(WL_END <= WL_STRIDE, "weights per layer");
constexpr size_t WS_X = WS_W + 2 * WL_STRIDE;
constexpr size_t WS_XB = WS_X + (size_t)MPAD * DM * 4;
constexpr size_t WS_Z = WS_XB + (size_t)MPAD * DM * 2;
constexpr size_t WS_ATT = WS_Z + (size_t)MPAD * NIN * 2;
constexpr size_t WS_SP = WS_ATT + (size_t)MPAD * 256 * 2;
constexpr size_t WS_MIX = WS_SP + (size_t)MPAD * 512 * 2;
constexpr size_t WS_KC = WS_MIX + (size_t)MPAD * DM * 2;
constexpr size_t WS_VC = WS_KC + (size_t)NB * 12 * SEQ * 64 * 2;
constexpr size_t WS_END = WS_VC + (size_t)NB * 12 * SEQ * 64 * 2;

struct Args { const float* in[22]; float* out; unsigned char* ws; int ph_lo, ph_hi; };

__device__ __forceinline__ unsigned f2bf(float f) { unsigned u = __builtin_bit_cast(unsigned, f); return (u + 0x7fffu + ((u >> 16) & 1u)) >> 16; }
__device__ __forceinline__ unsigned pk2(float lo, float hi) { return pg8::cvt_pk_bf16(lo, hi); }
__device__ __forceinline__ float bflo(unsigned w) { return __builtin_bit_cast(float, w << 16); }
__device__ __forceinline__ float bfhi(unsigned w) { return __builtin_bit_cast(float, w & 0xffff0000u); }
__device__ __forceinline__ float fexp2(float x) { return __builtin_amdgcn_exp2f(x); }
__device__ __forceinline__ float frcp(float x) { return __builtin_amdgcn_rcpf(x); }
__device__ __forceinline__ float sigmoidf_(float x) { return frcp(1.0f + fexp2(-LOG2E * x)); }
__device__ __forceinline__ float gelu_tanh(float x) {
    const float t = x * (1.0f + 0.044715f * x * x) * (2.0f * 0.7978845608028654f);
    return x * frcp(1.0f + fexp2(-LOG2E * t));
}
__device__ __forceinline__ float wave_sum(float v) {
#pragma unroll
    for (int o = 1; o < 64; o <<= 1) v += __shfl_xor(v, o);
    return v;
}
__device__ __forceinline__ float wave_max(float v) {
#pragma unroll
    for (int o = 1; o < 64; o <<= 1) v = fmaxf(v, __shfl_xor(v, o));
    return v;
}

#define XB_TMO      128
#define XB_XCNT(j)  (256  + 64 * (j))
#define XB_XSUB(j)  (1280 + 64 * (j))
#define XB_XGEN(j)  (2304 + 64 * (j))
#define XB_TOP      3328
#define XB_TOPGEN   3392
#define XCD_BAR_WORDS 3456
#define XB_SPIN_CAP (1u << 18)

__device__ __forceinline__ unsigned xb_ld(unsigned* p)              { return __hip_atomic_load(p, __ATOMIC_RELAXED, __HIP_MEMORY_SCOPE_AGENT); }
__device__ __forceinline__ unsigned xb_add(unsigned* p, unsigned v) { return __hip_atomic_fetch_add(p, v, __ATOMIC_RELAXED, __HIP_MEMORY_SCOPE_AGENT); }
__device__ __forceinline__ unsigned xb_xcc_id() { return (unsigned)__builtin_amdgcn_s_getreg((3 << 11) | 20) & 0xFu; }
#define XB_SPIN(cond, bar) do { unsigned _sp = 0; while (cond) { __builtin_amdgcn_s_sleep(1); \
    if ((++_sp & 255u) == 0u) { if (xb_ld(&(bar)[XB_TMO])) break; if (_sp > XB_SPIN_CAP) { atomicAdd(&(bar)[XB_TMO], 1u); break; } } } } while (0)

struct XcdBarrier {
    unsigned* bar; unsigned x;
    volatile LAS unsigned* st;
};

__device__ __forceinline__ XcdBarrier xcd_barrier_post(unsigned* bar, volatile LAS unsigned* st) {
    XcdBarrier b; b.bar = bar; b.x = xb_xcc_id(); b.st = st;
    if (threadIdx.x == 0) (void)xb_add(&bar[XB_XCNT(b.x)], 1u);
    return b;
}
__device__ __forceinline__ void xcd_barrier_complete(unsigned* bar, unsigned x, unsigned& nloc, unsigned& nx) {
    const unsigned G = gridDim.x * gridDim.y * gridDim.z;
    unsigned sum, cnt, mine, sp = 0u;
    for (;;) {
        sum = 0u; cnt = 0u; mine = 0u;
#pragma unroll
        for (unsigned j = 0; j < 16; ++j) { const unsigned c = xb_ld(&bar[XB_XCNT(j)]); sum += c; cnt += (c > 0u) ? 1u : 0u; mine = (j == x) ? c : mine; }
        if (sum == G) break;
        __builtin_amdgcn_s_sleep(1);
        if ((++sp & 255u) == 0u) { if (xb_ld(&bar[XB_TMO])) break; if (sp > XB_SPIN_CAP) { atomicAdd(&bar[XB_TMO], 1u); break; } }
    }
    nloc = mine > 0u ? mine : 1u; nx = cnt > 0u ? cnt : 1u;
}

__device__ __forceinline__ void xcd_barrier(const XcdBarrier& b) {
    asm volatile("s_waitcnt vmcnt(0)" ::: "memory");
    __syncthreads();
    if (threadIdx.x == 0) {
        unsigned* bar = b.bar;
        __builtin_amdgcn_s_waitcnt(0);
        unsigned nloc = b.st[0], nx = b.st[1];
        if (nloc == 0u) { xcd_barrier_complete(bar, b.x, nloc, nx); b.st[0] = nloc; b.st[1] = nx; }
        const unsigned old = xb_add(&bar[XB_XSUB(b.x)], 1u);
        const unsigned gen = old / nloc;
        if (old + 1u == (gen + 1u) * nloc) {
            __builtin_amdgcn_fence(__ATOMIC_RELEASE, "agent");
            asm volatile("s_waitcnt vmcnt(0)" ::: "memory");
            const unsigned og = xb_add(&bar[XB_TOP], 1u);
            const unsigned tg = og / nx;
            if (og + 1u == (tg + 1u) * nx) xb_add(&bar[XB_TOPGEN], 1u);
            else XB_SPIN(xb_ld(&bar[XB_TOPGEN]) == tg, bar);
            __builtin_amdgcn_fence(__ATOMIC_ACQUIRE, "agent");
            xb_add(&bar[XB_XGEN(b.x)], 1u);
            asm volatile("s_waitcnt vmcnt(0)" ::: "memory");
        } else {
            XB_SPIN(xb_ld(&bar[XB_XGEN(b.x)]) == gen, bar);
            __builtin_amdgcn_fence(__ATOMIC_ACQUIRE, "agent");
            asm volatile("s_waitcnt vmcnt(0)" ::: "memory");
        }
    }
    __syncthreads();
}

constexpr size_t WS_CTL0 = 768 * 1024, WS_CTL_BYTES = 32 * 1024;
constexpr size_t WS_BAR = 768 * 1024;
constexpr size_t WS_PCNT = 768 * 1024 + 16 * 1024;
static_assert(XCD_BAR_WORDS * 4 <= 16 * 1024 && WS_PCNT + 64 * 256 <= WS_CTL0 + WS_CTL_BYTES, "control words inside the memset region");
constexpr int LDS_MISC = 147456 - 64;

struct EpiGU {
    static constexpr bool PERM = true, AFTER_DRAIN = false;
    bf16* H; const float* ss;
    __device__ __forceinline__ void operator()(const f32x4 (&acc)[2][2][4][2], const pg8::Unit& u, int wr, int wc, int fr, int fq) const {
        const int row0 = u.pm * 256 + wr * 64 + fr, col0 = u.pn * 128 + wc * 32 + 8 * fq;
#pragma unroll
        for (int ai = 0; ai < 2; ++ai)
#pragma unroll
            for (int m = 0; m < 4; ++m) {
                const int row = row0 + ai * 128 + m * 16;
                const float r = rsqrtf(ss[row] * (1.0f / DM) + EPS);
                unsigned w[4];
#pragma unroll
                for (int n = 0; n < 2; ++n) {
                    float hv[4];
#pragma unroll
                    for (int e = 0; e < 4; ++e) { const float ga_ = acc[ai][0][m][n][e], ua_ = acc[ai][1][m][n][e]; hv[e] = (ga_ * ua_) * ((r * r) * frcp(1.0f + fexp2(ga_ * (r * -LOG2E)))); }
                    w[2 * n] = pk2(hv[0], hv[1]); w[2 * n + 1] = pk2(hv[2], hv[3]);
                }
                *(u32x4*)(H + (size_t)row * DFF + col0) = (u32x4){w[0], w[1], w[2], w[3]};
            }
    }
};
template <bool F32IN> struct EpiResT {
    static constexpr bool PERM = true, AFTER_DRAIN = false;
    const float* Xin; bf16* XB; float* ssn; float alpha;
    __device__ __forceinline__ void operator()(const f32x4 (&acc)[2][2][4][2], const pg8::Unit& u, int wr, int wc, int fr, int fq) const {
        const int row0 = u.pm * 256 + wr * 64 + fr, col0 = u.pn * 256 + wc * 32 + 8 * fq;
        if constexpr (!F32IN) {
            u32x4 xw[2][4][2];
#pragma unroll
            for (int ai = 0; ai < 2; ++ai)
#pragma unroll
                for (int m = 0; m < 4; ++m)
#pragma unroll
                    for (int bj = 0; bj < 2; ++bj) xw[ai][m][bj] = *(const u32x4*)(XB + (size_t)(row0 + ai * 128 + m * 16) * DM + col0 + bj * 128);
#pragma unroll
            for (int ai = 0; ai < 2; ++ai)
#pragma unroll
                for (int m = 0; m < 4; ++m) {
                    const int row = row0 + ai * 128 + m * 16;
                    float s = 0.f;
#pragma unroll
                    for (int bj = 0; bj < 2; ++bj) {
                        const u32x4 w = xw[ai][m][bj];
                        const f32x4 x0 = (f32x4){bflo(w.x), bfhi(w.x), bflo(w.y), bfhi(w.y)} + acc[ai][bj][m][0] * alpha, x1 = (f32x4){bflo(w.z), bfhi(w.z), bflo(w.w), bfhi(w.w)} + acc[ai][bj][m][1] * alpha;
                        *(u32x4*)(XB + (size_t)row * DM + col0 + bj * 128) = (u32x4){pk2(x0[0], x0[1]), pk2(x0[2], x0[3]), pk2(x1[0], x1[1]), pk2(x1[2], x1[3])};
                        s += ((x0[0] * x0[0] + x0[1] * x0[1]) + (x0[2] * x0[2] + x0[3] * x0[3])) + ((x1[0] * x1[0] + x1[1] * x1[1]) + (x1[2] * x1[2] + x1[3] * x1[3]));
                    }
                    s += __shfl_xor(s, 16); s += __shfl_xor(s, 32);
                    if (fq == 0) unsafeAtomicAdd(ssn + row, s);
                }
        } else {
#pragma unroll
        for (int ai = 0; ai < 2; ++ai) {
            f32x4 xin[4][2][2];
#pragma unroll
            for (int m = 0; m < 4; ++m)
#pragma unroll
                for (int bj = 0; bj < 2; ++bj) {
                    const size_t off = (size_t)(row0 + ai * 128 + m * 16) * DM + col0 + bj * 128;
                    xin[m][bj][0] = *(const f32x4*)(Xin + off); xin[m][bj][1] = *(const f32x4*)(Xin + off + 4);
                }
#pragma unroll
            for (int m = 0; m < 4; ++m) {
                const int row = row0 + ai * 128 + m * 16;
                float s = 0.f;
#pragma unroll
                for (int bj = 0; bj < 2; ++bj) {
                    const size_t off = (size_t)row * DM + col0 + bj * 128;
                    const f32x4 x0 = xin[m][bj][0] + acc[ai][bj][m][0] * alpha, x1 = xin[m][bj][1] + acc[ai][bj][m][1] * alpha;
                    *(u32x4*)(XB + off) = (u32x4){pk2(x0[0], x0[1]), pk2(x0[2], x0[3]), pk2(x1[0], x1[1]), pk2(x1[2], x1[3])};
                    s += ((x0[0] * x0[0] + x0[1] * x0[1]) + (x0[2] * x0[2] + x0[3] * x0[3])) + ((x1[0] * x1[0] + x1[1] * x1[1]) + (x1[2] * x1[2] + x1[3] * x1[3]));
                }
                s += __shfl_xor(s, 16); s += __shfl_xor(s, 32);
                if (fq == 0) unsafeAtomicAdd(ssn + row, s);
            }
        }
        }
    }
};
struct EpiResFinal {
    static constexpr bool PERM = true, AFTER_DRAIN = false;
    const bf16* Xin; float* Y; float* ssn; unsigned* pcnt; const float* gain; float alpha;
    __device__ __forceinline__ void operator()(const f32x4 (&acc)[2][2][4][2], const pg8::Unit& u, int wr, int wc, int fr, int fq) const {
        const int row0 = u.pm * 256 + wr * 64 + fr, col0 = u.pn * 256 + wc * 32 + 8 * fq;
#pragma unroll
        for (int ai = 0; ai < 2; ++ai) {
            u32x4 xw[4][2];
#pragma unroll
            for (int m = 0; m < 4; ++m)
#pragma unroll
                for (int bj = 0; bj < 2; ++bj) xw[m][bj] = *(const u32x4*)(Xin + (size_t)(row0 + ai * 128 + m * 16) * DM + col0 + bj * 128);
#pragma unroll
            for (int m = 0; m < 4; ++m) {
                float s = 0.f;
#pragma unroll
                for (int bj = 0; bj < 2; ++bj) {
                    const u32x4 w = xw[m][bj];
                    const f32x4 x0 = (f32x4){bflo(w.x), bfhi(w.x), bflo(w.y), bfhi(w.y)} + acc[ai][bj][m][0] * alpha, x1 = (f32x4){bflo(w.z), bfhi(w.z), bflo(w.w), bfhi(w.w)} + acc[ai][bj][m][1] * alpha;
                    s += ((x0[0] * x0[0] + x0[1] * x0[1]) + (x0[2] * x0[2] + x0[3] * x0[3])) + ((x1[0] * x1[0] + x1[1] * x1[1]) + (x1[2] * x1[2] + x1[3] * x1[3]));
                }
                s += __shfl_xor(s, 16); s += __shfl_xor(s, 32);
                if (fq == 0) unsafeAtomicAdd(ssn + row0 + ai * 128 + m * 16, s);
            }
        }
        asm volatile("s_waitcnt vmcnt(0)" ::: "memory");
        unsigned* cnt = pcnt + 64 * u.pm;
        if ((threadIdx.x & 63) == 0) __hip_atomic_fetch_add(cnt, 1u, __ATOMIC_RELAXED, __HIP_MEMORY_SCOPE_AGENT);
        { unsigned sp = 0; while ((unsigned)__builtin_amdgcn_readfirstlane(__hip_atomic_load(cnt, __ATOMIC_RELAXED, __HIP_MEMORY_SCOPE_AGENT)) < 32u && ++sp < (1u << 20)) __builtin_amdgcn_s_sleep(2); }
        asm volatile("" ::: "memory");
        f32x4 gv[2][2];
#pragma unroll
        for (int bj = 0; bj < 2; ++bj)
#pragma unroll
            for (int n = 0; n < 2; ++n) gv[bj][n] = *(const f32x4*)(gain + col0 + bj * 128 + 4 * n);
#pragma unroll
        for (int ai = 0; ai < 2; ++ai) {
            u32x4 xw[4][2]; float rr[4];
#pragma unroll
            for (int m = 0; m < 4; ++m) {
                const int row = row0 + ai * 128 + m * 16;
                rr[m] = rsqrtf(__hip_atomic_load(ssn + row, __ATOMIC_RELAXED, __HIP_MEMORY_SCOPE_AGENT) * (1.0f / DM) + EPS);
#pragma unroll
                for (int bj = 0; bj < 2; ++bj) xw[m][bj] = *(const u32x4*)(Xin + (size_t)row * DM + col0 + bj * 128);
            }
#pragma unroll
            for (int m = 0; m < 4; ++m)
#pragma unroll
                for (int bj = 0; bj < 2; ++bj) {
                    const int row = row0 + ai * 128 + m * 16;
                    const u32x4 w = xw[m][bj];
                    const f32x4 x0 = (f32x4){bflo(w.x), bfhi(w.x), bflo(w.y), bfhi(w.y)} + acc[ai][bj][m][0] * alpha, x1 = (f32x4){bflo(w.z), bfhi(w.z), bflo(w.w), bfhi(w.w)} + acc[ai][bj][m][1] * alpha;
                    float* yp = Y + (size_t)row * DM + col0 + bj * 128;
                    *(f32x4*)yp = x0 * rr[m] * gv[bj][0]; *(f32x4*)(yp + 4) = x1 * rr[m] * gv[bj][1];
                }
        }
    }
};
struct EpiIn {
    static constexpr bool PERM = true, AFTER_DRAIN = false;
    bf16* Z; const float* ss; float* ssv; float* out; int layer; bf16* KC; bf16* VC;
    __device__ __forceinline__ void operator()(const f32x4 (&acc)[2][2][4][2], const pg8::Unit& u, int wr, int wc, int fr, int fq) const {
        const int pn = u.pn;
        const int row0 = u.pm * 256 + wr * 64 + fr, cc0 = wc * 32 + 8 * fq;
        const int type = pn < 3 ? 0 : pn < 9 ? 1 : pn < 11 ? 2 : pn < 13 ? 3 : 4;
        const int g = (pn - 3) % 3, kvsel = (pn - 3) / 3;
        const int keep = 128 << (2 * g);
        const size_t okp = g == 0 ? O_KP0 : g == 1 ? O_KP1 : O_KP2;
        const size_t oks = g == 0 ? O_KS0 : g == 1 ? O_KS1 : O_KS2;
        float rr[2][4];
#pragma unroll
        for (int ai = 0; ai < 2; ++ai)
#pragma unroll
            for (int m = 0; m < 4; ++m) rr[ai][m] = ss[row0 + ai * 128 + m * 16];
#pragma unroll
        for (int ai = 0; ai < 2; ++ai)
#pragma unroll
            for (int m = 0; m < 4; ++m) {
                const int row = row0 + ai * 128 + m * 16;
                const float r = rsqrtf(rr[ai][m] * (1.0f / DM) + EPS);
                float sv = 0.f;
#pragma unroll
                for (int bj = 0; bj < 2; ++bj) {
                    f32x4 v0 = acc[ai][bj][m][0] * r, v1 = acc[ai][bj][m][1] * r;
                    const int cc = bj * 128 + cc0;
                    if (type == 0) { v0 = v0 * QSCALE; v1 = v1 * QSCALE; }
                    else if (type == 1) {
                        if (row < MP) {
                            const int b = row >> 11, t = row & 2047, trow = t - (SEQ - keep);
                            if (trow >= 0) { float* o = out + okp + ((size_t)((layer * NB + b) * keep + trow) * 2 + kvsel) * 256 + cc; *(f32x4*)o = v0; *(f32x4*)(o + 4) = v1; }
                        } else if (row < MR) {
                            float* o = out + oks + ((size_t)(layer * MS + (row - MP)) * 2 + kvsel) * 256 + cc; *(f32x4*)o = v0; *(f32x4*)(o + 4) = v1;
                        }
                    } else if (type == 2 || type == 3) {
#pragma unroll
                        for (int e = 0; e < 4; ++e) { v0[e] = gelu_tanh(v0[e]); v1[e] = gelu_tanh(v1[e]); }
                        if (type == 3) sv += (v0[0] * v0[0] + v0[1] * v0[1]) + (v0[2] * v0[2] + v0[3] * v0[3]) + (v1[0] * v1[0] + v1[1] * v1[1]) + (v1[2] * v1[2] + v1[3] * v1[3]);
                    } else {
#pragma unroll
                        for (int e = 0; e < 4; ++e) { v0[e] = sigmoidf_(v0[e]); v1[e] = sigmoidf_(v1[e]); }
                    }
                    const u32x4 pk = (u32x4){pk2(v0[0], v0[1]), pk2(v0[2], v0[3]), pk2(v1[0], v1[1]), pk2(v1[2], v1[3])};
                    if (type == 1 && row < MP) {
                        const int b = row >> 11, t = row & 2047, posp = (t & ((1 << (2 * g)) - 1)) * (SEQ >> (2 * g)) + (t >> (2 * g));
                        *(u32x4*)((kvsel ? VC : KC) + ((size_t)((b * 3 + g) * 4 + (cc >> 6)) * SEQ + posp) * 64 + (cc & 63)) = pk;
                    } else *(u32x4*)(Z + (size_t)row * NIN + pn * 256 + cc) = pk;
                }
                if (type == 3) { sv += __shfl_xor(sv, 16); sv += __shfl_xor(sv, 32); if (fq == 0) unsafeAtomicAdd(ssv + row, sv); }
            }
    }
};
template <int PASS> struct EpiProj {
    static constexpr bool PERM = true, AFTER_DRAIN = false;
    bf16* MIX; const bf16* Z;
    __device__ __forceinline__ void operator()(const f32x4 (&acc)[2][2][4][2], const pg8::Unit& u, int wr, int wc, int fr, int fq) const {
        const int row0 = u.pm * 256 + wr * 64 + fr, col0 = u.pn * 256 + wc * 32 + 8 * fq;
        u32x4 gall[2][4][2];
        if (PASS == 0) {
#pragma unroll
            for (int ai = 0; ai < 2; ++ai)
#pragma unroll
                for (int m = 0; m < 4; ++m)
#pragma unroll
                    for (int bj = 0; bj < 2; ++bj) gall[ai][m][bj] = *(const u32x4*)(Z + (size_t)(row0 + ai * 128 + m * 16) * NIN + C_GA + col0 + bj * 128);
        }
#pragma unroll
        for (int ai = 0; ai < 2; ++ai) {
            u32x4 gw[4][2], pw[4][2];
#pragma unroll
            for (int m = 0; m < 4; ++m)
#pragma unroll
                for (int bj = 0; bj < 2; ++bj) {
                    const size_t row = (size_t)(row0 + ai * 128 + m * 16);
                    if (PASS == 0) gw[m][bj] = gall[ai][m][bj];
                    else { gw[m][bj] = *(const u32x4*)(Z + row * NIN + C_GB + col0 + bj * 128); pw[m][bj] = *(const u32x4*)(MIX + row * DM + col0 + bj * 128); }
                }
#pragma unroll
            for (int m = 0; m < 4; ++m)
#pragma unroll
                for (int bj = 0; bj < 2; ++bj) {
                    const size_t row = (size_t)(row0 + ai * 128 + m * 16);
                    const u32x4 g = gw[m][bj];
                    const f32x4 a0 = acc[ai][bj][m][0], a1 = acc[ai][bj][m][1];
                    float o[8];
                    o[0] = bflo(g[0]) * a0[0]; o[1] = bfhi(g[0]) * a0[1]; o[2] = bflo(g[1]) * a0[2]; o[3] = bfhi(g[1]) * a0[3];
                    o[4] = bflo(g[2]) * a1[0]; o[5] = bfhi(g[2]) * a1[1]; o[6] = bflo(g[3]) * a1[2]; o[7] = bfhi(g[3]) * a1[3];
                    if (PASS == 1) {
                        const u32x4 p = pw[m][bj];
                        o[0] += bflo(p[0]); o[1] += bfhi(p[0]); o[2] += bflo(p[1]); o[3] += bfhi(p[1]);
                        o[4] += bflo(p[2]); o[5] += bfhi(p[2]); o[6] += bflo(p[3]); o[7] += bfhi(p[3]);
                    }
                    *(u32x4*)(MIX + row * DM + col0 + bj * 128) = (u32x4){pk2(o[0], o[1]), pk2(o[2], o[3]), pk2(o[4], o[5]), pk2(o[6], o[7])};
                }
            asm volatile("" ::: "memory");
        }
    }
};

__device__ __forceinline__ void transpose_item(const float* W, int K, int N, bf16* WT, int k0, int n0, int dst_row0, const float* gain, LAS float* scr, int lane) {
    f32x4 v[16];
    const int lr = lane >> 4, lc = (lane & 15) * 4;
    const float* src = W + (size_t)(k0 + lr) * N + n0 + lc;
#pragma unroll
    for (int i = 0; i < 16; ++i) v[i] = *(const f32x4*)(src + (size_t)(4 * i) * N);
    const int c = lane & 7;
    f32x4 g0 = (f32x4){1.f, 1.f, 1.f, 1.f}, g1 = g0;
    if (gain) { g0 = *(const f32x4*)(gain + k0 + 8 * c); g1 = *(const f32x4*)(gain + k0 + 8 * c + 4); }
#pragma unroll
    for (int i = 0; i < 16; ++i) { LAS float* d = scr + (4 * i + lr) * 65 + lc; d[0] = v[i][0]; d[1] = v[i][1]; d[2] = v[i][2]; d[3] = v[i][3]; }
    asm volatile("s_waitcnt lgkmcnt(0)" ::: "memory");
#pragma unroll
    for (int j = 0; j < 8; ++j) { const int n = (lane >> 3) + 8 * j; const LAS float* sp = scr + (8 * c) * 65 + n;
        u32x4 o; o.x = pk2(sp[0 * 65] * g0[0], sp[1 * 65] * g0[1]); o.y = pk2(sp[2 * 65] * g0[2], sp[3 * 65] * g0[3]); o.z = pk2(sp[4 * 65] * g1[0], sp[5 * 65] * g1[1]); o.w = pk2(sp[6 * 65] * g1[2], sp[7 * 65] * g1[3]);
        *(u32x4*)(WT + (size_t)(dst_row0 + n) * K + k0 + 8 * c) = o; }
    asm volatile("s_waitcnt lgkmcnt(0)" ::: "memory");
}
__device__ __forceinline__ void conv_matrix_item(const float* W, int K, int N, bf16* WT, int item, int mode  , const float* gain, LAS float* scr, int lane) {
    const int nblk = N / 64, kb = item / nblk, nb = item % nblk, n0 = 64 * nb;
    const int dst = mode == 0 ? n0 : ((n0 >> 7) * 256 + (n0 & 127) + (mode == 2 ? 128 : 0));
    transpose_item(W, K, N, WT, 64 * kb, n0, dst, gain, scr, lane);
}

constexpr int I_G = (DM / 64) * (DFF / 64), I_D = (DFF / 64) * (DM / 64), I_IN = (DM / 64) * (NIN / 64), I_PA = (256 / 64) * (DM / 64), I_PS = (512 / 64) * (DM / 64), I_WO = (DM / 64) * (DM / 64);
constexpr int I_LAYER = 6 * I_G + I_IN + I_PA + I_PS + I_WO;
constexpr int I_FFN1 = 3 * I_G, I_MIXW = I_IN + I_PA + I_PS + I_WO, I_FFN2_0 = I_FFN1 + I_MIXW;
static_assert(I_G == I_D, "items");
__device__ __forceinline__ void conv_layer_item(const Args& a, int l, int r, LAS float* scr, int lane) {
    unsigned char* wl = a.ws + WS_W + (size_t)l * WL_STRIDE;
    if (r < I_G) { conv_matrix_item(a.in[6] + (size_t)l * DM * DFF, DM, DFF, (bf16*)(wl + WL_GU1), r, 1, a.in[5] + l * DM, scr, lane); return; } r -= I_G;
    if (r < I_G) { conv_matrix_item(a.in[7] + (size_t)l * DM * DFF, DM, DFF, (bf16*)(wl + WL_GU1), r, 2, a.in[5] + l * DM, scr, lane); return; } r -= I_G;
    if (r < I_D) { conv_matrix_item(a.in[8] + (size_t)l * DFF * DM, DFF, DM, (bf16*)(wl + WL_DN1), r, 0, nullptr, scr, lane); return; } r -= I_D;
    if (r < I_IN) { conv_matrix_item(a.in[10] + (size_t)l * DM * NIN, DM, NIN, (bf16*)(wl + WL_IN), r, 0, a.in[9] + l * DM, scr, lane); return; } r -= I_IN;
    if (r < I_PA) { conv_matrix_item(a.in[14] + (size_t)l * 256 * DM, 256, DM, (bf16*)(wl + WL_PA), r, 0, nullptr, scr, lane); return; } r -= I_PA;
    if (r < I_PS) { conv_matrix_item(a.in[15] + (size_t)l * 512 * DM, 512, DM, (bf16*)(wl + WL_PS), r, 0, nullptr, scr, lane); return; } r -= I_PS;
    if (r < I_WO) { conv_matrix_item(a.in[16] + (size_t)l * DM * DM, DM, DM, (bf16*)(wl + WL_WO), r, 0, nullptr, scr, lane); return; } r -= I_WO;
    if (r < I_G) { conv_matrix_item(a.in[18] + (size_t)l * DM * DFF, DM, DFF, (bf16*)(wl + WL_GU2), r, 1, a.in[17] + l * DM, scr, lane); return; } r -= I_G;
    if (r < I_G) { conv_matrix_item(a.in[19] + (size_t)l * DM * DFF, DM, DFF, (bf16*)(wl + WL_GU2), r, 2, a.in[17] + l * DM, scr, lane); return; } r -= I_G;
    conv_matrix_item(a.in[20] + (size_t)l * DFF * DM, DFF, DM, (bf16*)(wl + WL_DN2), r, 0, nullptr, scr, lane);
}
__device__ __forceinline__ void conv_items(const Args& a, LAS unsigned char* lds, int lo, int hi, int widx, int nw, int wave, int lane) {
    LAS float* scr = (LAS float*)(lds + wave * 16640);
    for (int it = lo + widx; it < hi; it += nw) conv_layer_item(a, it / I_LAYER, it % I_LAYER, scr, lane);
}
__device__ __forceinline__ void conv_in_idle_tail(const Args& a, LAS unsigned char* lds, int nwg_tiles, int lo, int hi, int wave, int lane) {
    const int G = gridDim.x, wg = blockIdx.x;
    const int first_idle = nwg_tiles % G;
    if (wg < first_idle) return;
    conv_items(a, lds, lo, hi, (wg - first_idle) * NWAVES + wave, (G - first_idle) * NWAVES, wave, lane);
}

__device__ __forceinline__ void phase_prologue(const Args& a, LAS unsigned char* lds, int gw, int NGW, int lane, int wave) {
    unsigned char* ws = a.ws;
    { float* ss = (float*)(ws + WS_SS); const int gt = gw * 64 + lane, NT = NGW * 64;
      for (int i = MPAD + gt; i < 9 * MPAD; i += NT) ss[i] = 0.f; }
    conv_items(a, lds, 0, 2 * I_LAYER, gw, NGW, wave, lane);
    { const int gt = gw * 64 + lane, NT = NGW * 64;
      for (int i = gt; i < 2 * 4 * 128 * 128; i += NT) { const int l = i >> 16, rem = i & 65535, t = (rem >> 7) & 127, s = rem & 127;
          const float v = s <= t ? a.in[12][i] : 0.f; ((bf16*)(ws + WS_W + (size_t)l * WL_STRIDE + WL_TRIL))[rem] = (bf16)f2bf(v); } }
    bf16* XB = (bf16*)(ws + WS_XB); float* ss0 = (float*)(ws + WS_SS);
    for (int m = gw; m < MPAD; m += NGW) {
        f32x4 v[4]; float s = 0.f;
        if (m < MR) { const float* src = m < MP ? a.in[0] + (size_t)m * DM : a.in[1] + (size_t)(m - MP) * DM;
#pragma unroll
            for (int j = 0; j < 4; ++j) { v[j] = *(const f32x4*)(src + 4 * lane + 256 * j); s += (v[j][0] * v[j][0] + v[j][1] * v[j][1]) + (v[j][2] * v[j][2] + v[j][3] * v[j][3]); }
        } else {
#pragma unroll
            for (int j = 0; j < 4; ++j) v[j] = (f32x4){0.f, 0.f, 0.f, 0.f};
        }
        s = wave_sum(s);
#pragma unroll
        for (int j = 0; j < 4; ++j) *(u32x2*)(XB + (size_t)m * DM + 4 * lane + 256 * j) = (u32x2){pk2(v[j][0], v[j][1]), pk2(v[j][2], v[j][3])};
        if (lane == 0) ss0[m] = s;
    }
}

#define MFMA32(a, b, c) __builtin_amdgcn_mfma_f32_32x32x16_bf16((a), (b), (c), 0, 0, 0)
typedef short v4i16_t __attribute__((ext_vector_type(4)));
__device__ __forceinline__ s16x4 tr_read(const LAS unsigned char* p) { return __builtin_bit_cast(s16x4, __builtin_amdgcn_ds_read_tr16_b64_v4i16((LAS v4i16_t*)p)); }
__device__ __forceinline__ float alibi_slope2(int hidx) { return fexp2(-8.0f * (float)(hidx + 1) / 12.0f) * LOG2E; }

constexpr int VP = 192;
constexpr int KP = 144;
constexpr int ATT_WAVE_LDS = 32 * VP + 32 * KP;

__device__ __forceinline__ void attn_prompt_task(const bf16* Z, const bf16* KC, const bf16* VC, bf16* AS, int task, LAS unsigned char* vl, int lane) {
    const int rho = task & 15, c5 = (task >> 4) & 3, islot = (task >> 6) & 3, b = task >> 8;
    const int ql = lane & 31, h = lane >> 5;
    const int t0 = 512 * c5 + rho, tq = t0 + 16 * ql, tmax = t0 + 496;
    const size_t rowq = (size_t)b * SEQ + tq;
    f32x16 o0, o1;
#pragma unroll
    for (int i = 0; i < 16; ++i) { o0[i] = 0.f; o1[i] = 0.f; }
    float mrun = -1e30f, lrun = 0.f;
    const int i16 = lane & 15, tq_ = i16 >> 2, tp = i16 & 3, blk = (lane >> 4) & 1;
    const int traddr = (4 * h + tq_) * VP + 32 * blk + 8 * tp;
    const int crow_ = lane >> 3, cchk = lane & 7;
    LAS unsigned char* kl = vl + 32 * VP;
    for (int g = 0; g < 3; ++g) {
        const int dil = 1 << (2 * g), W = 128 << (2 * g), nblk = g == 0 ? 20 : g == 1 ? 8 : 5;
        const float slope2 = alibi_slope2(g * 4 + islot);
        const int qcol = C_Q + g * 256 + islot * 64 + 8 * h;
        const int rres = tmax & (dil - 1), nper = SEQ >> (2 * g);
        const bf16* kbase = KC + ((size_t)((b * 3 + g) * 4 + islot) * SEQ + rres * nper) * 64;
        const bf16* vbase = VC + ((size_t)((b * 3 + g) * 4 + islot) * SEQ + rres * nper) * 64;
        bf16x8 qf[4];
#pragma unroll
        for (int st = 0; st < 4; ++st) qf[st] = *(const bf16x8*)(Z + rowq * NIN + qcol + 16 * st);
        const int lim = tq < W ? tq : W;
        u32x4 krn[4], vrn[4];
        {   const int jb0 = (tmax - dil * 31 - rres) >> (2 * g);
#pragma unroll
            for (int i = 0; i < 4; ++i) { int rj = jb0 + crow_ + 8 * i; rj = rj < 0 ? 0 : rj; krn[i] = *(const u32x4*)(kbase + (size_t)rj * 64 + 8 * cchk); vrn[i] = *(const u32x4*)(vbase + (size_t)rj * 64 + 8 * cchk); }
        }
        for (int c = 0; c < nblk; ++c) {
            const int kb = tmax - dil * (32 * c + 31);
            if (kb + 31 * dil < 0) break;
            u32x4 kr[4], vr[4];
#pragma unroll
            for (int i = 0; i < 4; ++i) { kr[i] = krn[i]; vr[i] = vrn[i]; }
            {
                const int jb1 = ((kb - rres) >> (2 * g)) - 32;
#pragma unroll
                for (int i = 0; i < 4; ++i) { int rj = jb1 + crow_ + 8 * i; rj = rj < 0 ? 0 : rj; krn[i] = *(const u32x4*)(kbase + (size_t)rj * 64 + 8 * cchk); vrn[i] = *(const u32x4*)(vbase + (size_t)rj * 64 + 8 * cchk); }
            }
#pragma unroll
            for (int i = 0; i < 4; ++i) { *(LAS u32x4*)(kl + (crow_ + 8 * i) * KP + 16 * cchk) = kr[i]; *(LAS u32x4*)(vl + (crow_ + 8 * i) * VP + 16 * cchk) = vr[i]; }
            asm volatile("s_waitcnt lgkmcnt(0)" ::: "memory");
            bf16x8 kf[4];
#pragma unroll
            for (int st = 0; st < 4; ++st) kf[st] = *(const LAS bf16x8*)(kl + ql * KP + 32 * st + 16 * h);
            const int dq = tq - kb - dil * 4 * h;
            const float binit = -slope2 * (float)dq, sd = slope2 * (float)dil;
            f32x16 sacc;
#pragma unroll
            for (int i = 0; i < 16; ++i) {
                const int ci = (i & 3) + 8 * (i >> 2);
                const int dist = dq - dil * ci;
                sacc[i] = ((unsigned)dist <= (unsigned)lim) ? fmaf(sd, (float)ci, binit) : -INFINITY;
            }
#pragma unroll
            for (int st = 0; st < 4; ++st) sacc = MFMA32(kf[st], qf[st], sacc);
            float mloc = fmaxf(fmaxf(fmaxf(sacc[0], sacc[1]), fmaxf(sacc[2], sacc[3])), fmaxf(fmaxf(sacc[4], sacc[5]), fmaxf(sacc[6], sacc[7])));
            mloc = fmaxf(mloc, fmaxf(fmaxf(fmaxf(sacc[8], sacc[9]), fmaxf(sacc[10], sacc[11])), fmaxf(fmaxf(sacc[12], sacc[13]), fmaxf(sacc[14], sacc[15]))));
            { auto sw = __builtin_amdgcn_permlane32_swap(__builtin_bit_cast(unsigned, mloc), __builtin_bit_cast(unsigned, mloc), false, false);
              mloc = fmaxf(__builtin_bit_cast(float, (unsigned)sw[0]), __builtin_bit_cast(float, (unsigned)sw[1])); }
            const float mnew = fmaxf(mrun, mloc);
            const float alpha = fexp2(mrun - mnew);
            mrun = mnew;
            float ps0 = 0.f, ps1 = 0.f;
#pragma unroll
            for (int i = 0; i < 16; i += 2) { const float p0 = fexp2(sacc[i] - mnew), p1 = fexp2(sacc[i + 1] - mnew); sacc[i] = p0; sacc[i + 1] = p1; ps0 += p0; ps1 += p1; }
            lrun = lrun * alpha + (ps0 + ps1);
            if (__builtin_amdgcn_ballot_w64(alpha != 1.0f) != 0ull) {
#pragma unroll
                for (int i = 0; i < 16; ++i) { o0[i] *= alpha; o1[i] *= alpha; }
            }
            bf16x8 pb[2];
#pragma unroll
            for (int s = 0; s < 2; ++s) {
                u32x4 w; w.x = pk2(sacc[8 * s + 0], sacc[8 * s + 1]); w.y = pk2(sacc[8 * s + 2], sacc[8 * s + 3]); w.z = pk2(sacc[8 * s + 4], sacc[8 * s + 5]); w.w = pk2(sacc[8 * s + 6], sacc[8 * s + 7]);
                pb[s] = __builtin_bit_cast(bf16x8, w);
            }
            asm volatile("s_waitcnt lgkmcnt(0)" ::: "memory");
#pragma unroll
            for (int s = 0; s < 2; ++s) {
                const s16x4 a00 = tr_read(vl + traddr + (16 * s) * VP), a01 = tr_read(vl + traddr + (16 * s + 8) * VP);
                const s16x4 a10 = tr_read(vl + traddr + (16 * s) * VP + 64), a11 = tr_read(vl + traddr + (16 * s + 8) * VP + 64);
                const bf16x8 va0 = __builtin_shufflevector(a00, a01, 0, 1, 2, 3, 4, 5, 6, 7), va1 = __builtin_shufflevector(a10, a11, 0, 1, 2, 3, 4, 5, 6, 7);
                o0 = MFMA32(va0, pb[s], o0);
                o1 = MFMA32(va1, pb[s], o1);
            }
            asm volatile("s_waitcnt lgkmcnt(0)" ::: "memory");
        }
    }
    const float ltot = lrun + __shfl_xor(lrun, 32);
    const float inv = 1.0f / ltot;
    bf16* op = AS + rowq * 256 + islot * 64 + 4 * h;
#pragma unroll
    for (int g4 = 0; g4 < 4; ++g4) {
        *(u32x2*)(op + 8 * g4) = (u32x2){pk2(o0[4 * g4] * inv, o0[4 * g4 + 1] * inv), pk2(o0[4 * g4 + 2] * inv, o0[4 * g4 + 3] * inv)};
        *(u32x2*)(op + 32 + 8 * g4) = (u32x2){pk2(o1[4 * g4] * inv, o1[4 * g4 + 1] * inv), pk2(o1[4 * g4 + 2] * inv, o1[4 * g4 + 3] * inv)};
    }
}

__device__ __forceinline__ void attn_sample_unit(const Args& a, const bf16* Z, int layer, int task, int g, LAS float* sc, LAS float* part, int lane) {
    const int j = task & 3, islot = (task >> 2) & 3, b = task >> 4;
    const size_t rowq = (size_t)MP + b * DS + j;
    const int sub = lane >> 4, l16 = lane & 15;
    const int dil = 1 << (2 * g), W = 128 << (2 * g);
    const float slope2 = alibi_slope2(g * 4 + islot);
    const float* cache = (g == 0 ? a.in[2] : g == 1 ? a.in[3] : a.in[4]) + ((size_t)(layer * DB + b) * W) * 512 + islot * 64 + 4 * l16;
    f32x4 q4;
    { const u32x2 qw = *(const u32x2*)(Z + rowq * NIN + C_Q + g * 256 + islot * 64 + 4 * l16); q4 = (f32x4){bflo(qw.x), bfhi(qw.x), bflo(qw.y), bfhi(qw.y)}; }
    const int nnew = g == 0 ? j + 1 : 1;
    float sn = -INFINITY; f32x4 vn4;
    {   const int i = sub < nnew ? sub : 0;
        const bf16* rp = Z + ((size_t)MP + b * DS + (j - i * dil)) * NIN + g * 256 + islot * 64 + 4 * l16;
        const u32x2 kw = *(const u32x2*)(rp + C_K), vw = *(const u32x2*)(rp + C_V);
        float d = q4[0] * bflo(kw.x) + q4[1] * bfhi(kw.x) + q4[2] * bflo(kw.y) + q4[3] * bfhi(kw.y);
        d += __shfl_xor(d, 1); d += __shfl_xor(d, 2); d += __shfl_xor(d, 4); d += __shfl_xor(d, 8);
        if (sub < nnew) sn = d - slope2 * (float)(i * dil);
        vn4 = (f32x4){bflo(vw.x), bfhi(vw.x), bflo(vw.y), bfhi(vw.y)};
    }
    float gmax = sn;
    const size_t stride = (size_t)4 * dil * 512;
    const float* kp = cache + (size_t)(W + j - (nnew + sub) * dil) * 512;
#pragma unroll 1
    for (int hb = 0; hb < 2; ++hb) {
        f32x4 kw[16];
#pragma unroll
        for (int it = 0; it < 16; ++it) kw[it] = *(const f32x4*)(kp - (size_t)(16 * hb + it) * stride);
#pragma unroll
        for (int it = 0; it < 16; ++it) {
            const int i = nnew + 4 * (16 * hb + it) + sub;
            float d = (q4[0] * kw[it][0] + q4[1] * kw[it][1]) + (q4[2] * kw[it][2] + q4[3] * kw[it][3]);
            d += __shfl_xor(d, 1); d += __shfl_xor(d, 2); d += __shfl_xor(d, 4); d += __shfl_xor(d, 8);
            const float sv = i <= 128 ? d - slope2 * (float)(i * dil) : -INFINITY;
            sc[(16 * hb + it) * 64 + lane] = sv; gmax = fmaxf(gmax, sv);
        }
    }
    gmax = fmaxf(gmax, __shfl_xor(gmax, 16)); gmax = fmaxf(gmax, __shfl_xor(gmax, 32));
    float lrun; f32x4 o4;
    { const float p = fexp2(sn - gmax); lrun = p; o4 = vn4 * p; }
    asm volatile("s_waitcnt lgkmcnt(0)" ::: "memory");
#pragma unroll 1
    for (int hb = 0; hb < 2; ++hb) {
        f32x4 vw[16];
#pragma unroll
        for (int it = 0; it < 16; ++it) vw[it] = *(const f32x4*)(kp + 256 - (size_t)(16 * hb + it) * stride);
#pragma unroll
        for (int it = 0; it < 16; ++it) { const float p = fexp2(sc[(16 * hb + it) * 64 + lane] - gmax); lrun += p; o4 = o4 + vw[it] * p; }
    }
    lrun += __shfl_xor(lrun, 16); lrun += __shfl_xor(lrun, 32);
#pragma unroll
    for (int e = 0; e < 4; ++e) { float v = o4[e]; v += __shfl_xor(v, 16); v += __shfl_xor(v, 32); o4[e] = v; }
    if (sub == 0) *(LAS f32x4*)(part + 4 + 4 * l16) = o4;
    if (lane == 0) { part[0] = gmax; part[1] = lrun; }
    asm volatile("s_waitcnt lgkmcnt(0)" ::: "memory");
}
__device__ __forceinline__ void attn_sample_combine(bf16* AS, int task, const LAS float* part3, int d) {
    const int j = task & 3, islot = (task >> 2) & 3, b = task >> 4;
    const size_t rowq = (size_t)MP + b * DS + j;
    const float m0 = part3[0], m1 = part3[72], m2 = part3[144];
    const float M = fmaxf(m0, fmaxf(m1, m2));
    const float w0 = fexp2(m0 - M), w1 = fexp2(m1 - M), w2 = fexp2(m2 - M);
    const float L = w0 * part3[1] + w1 * part3[73] + w2 * part3[145];
    const float o = w0 * part3[4 + d] + w1 * part3[76 + d] + w2 * part3[148 + d];
    AS[rowq * 256 + islot * 64 + d] = (bf16)f2bf(o / L);
}

constexpr int GP = 320;
__device__ __forceinline__ void gmlp_prompt_unit(const Args& a, const bf16* Z, bf16* AS, const float* ssv, int layer, int unit, LAS unsigned char* lds, int tid, int wave, int lane) {
    const int gg = unit & 3, n = unit >> 2, m0 = n * 128;
    const bf16* Wt = (const bf16*)(a.ws + WS_W + (size_t)layer * WL_STRIDE + WL_TRIL) + gg * 128 * 128;
    const float* gain = a.in[11] + layer * 512 + gg * 128;
    const float* bias = a.in[13] + (layer * 4 + gg) * 128;
    __syncthreads();
    {
        const int row = tid >> 2, qt = tid & 3;
        const float rv = rsqrtf(ssv[m0 + row] * (1.0f / 512.0f) + EPS);
        const bf16* src = Z + (size_t)(m0 + row) * NIN + C_VS + gg * 128 + 32 * qt;
#pragma unroll
        for (int jj = 0; jj < 4; ++jj) {
            const u32x4 w = *(const u32x4*)(src + 8 * jj);
            const f32x4 g0 = *(const f32x4*)(gain + 32 * qt + 8 * jj), g1 = *(const f32x4*)(gain + 32 * qt + 8 * jj + 4);
            u32x4 o;
            o.x = pk2(bflo(w.x) * rv * g0[0], bfhi(w.x) * rv * g0[1]); o.y = pk2(bflo(w.y) * rv * g0[2], bfhi(w.y) * rv * g0[3]);
            o.z = pk2(bflo(w.z) * rv * g1[0], bfhi(w.z) * rv * g1[1]); o.w = pk2(bflo(w.w) * rv * g1[2], bfhi(w.w) * rv * g1[3]);
            *(LAS u32x4*)(lds + row * GP + (32 * qt + 8 * jj) * 2) = o;
        }
    }
    __syncthreads();
    const int ct = wave & 3, tl = lane & 31, h = lane >> 5;
    const int i16 = lane & 15, tq_ = i16 >> 2, tp = i16 & 3, blk = (lane >> 4) & 1;
    const int traddr = (8 * h + tq_) * GP + (32 * ct + 16 * blk + 4 * tp) * 2;
#pragma unroll
    for (int half = 0; half < 2; ++half) {
        const int tt = half == 0 ? (wave >> 2) : 3 - (wave >> 2);
        f32x16 acc;
#pragma unroll
        for (int i = 0; i < 16; ++i) acc[i] = 0.f;
        const bf16* wrow = Wt + (size_t)(32 * tt + tl) * 128 + 8 * h;
        const int nks = 2 * (tt + 1);
        bf16x8 wb[8];
#pragma unroll
        for (int ks = 0; ks < 8; ++ks) if (ks < nks) wb[ks] = *(const bf16x8*)(wrow + 16 * ks);
#pragma unroll
        for (int ks = 0; ks < 8; ++ks) if (ks < nks) {
            const s16x4 a0 = tr_read(lds + traddr + (16 * ks) * GP), a1 = tr_read(lds + traddr + (16 * ks + 4) * GP);
            const bf16x8 va = __builtin_shufflevector(a0, a1, 0, 1, 2, 3, 4, 5, 6, 7);
            acc = MFMA32(va, wb[ks], acc);
        }
        const int trow = 32 * tt + tl;
        const float bs = bias[trow];
        const size_t row = (size_t)m0 + trow;
#pragma unroll
        for (int i4 = 0; i4 < 4; ++i4) {
            const int c = 32 * ct + 8 * i4 + 4 * h;
            const u32x2 uw = *(const u32x2*)(Z + row * NIN + C_U + gg * 128 + c);
            const float z0 = (acc[4 * i4] + bs) * bflo(uw.x), z1 = (acc[4 * i4 + 1] + bs) * bfhi(uw.x), z2 = (acc[4 * i4 + 2] + bs) * bflo(uw.y), z3 = (acc[4 * i4 + 3] + bs) * bfhi(uw.y);
            *(u32x2*)(AS + row * 512 + gg * 128 + c) = (u32x2){pk2(z0, z1), pk2(z2, z3)};
        }
    }
}
__device__ __forceinline__ void gmlp_prompt_pair(const Args& a, const bf16* Z, bf16* AS, const float* ssv, int layer, int u0, LAS unsigned char* lds, int tid, int wave, int lane) {
    const int gg = u0 & 3;
    const bf16* Wt = (const bf16*)(a.ws + WS_W + (size_t)layer * WL_STRIDE + WL_TRIL) + gg * 128 * 128;
    const float* gain = a.in[11] + layer * 512 + gg * 128;
    const float* bias = a.in[13] + (layer * 4 + gg) * 128;
    const int row = tid >> 2, qt = tid & 3;
    const int ct = wave & 3, tl = lane & 31, h = lane >> 5;
    u32x4 vt[2][4]; float sv[2];
#pragma unroll
    for (int uu = 0; uu < 2; ++uu) {
        const int m0 = ((u0 + 256 * uu) >> 2) * 128;
        sv[uu] = ssv[m0 + row];
        const bf16* src = Z + (size_t)(m0 + row) * NIN + C_VS + gg * 128 + 32 * qt;
#pragma unroll
        for (int jj = 0; jj < 4; ++jj) vt[uu][jj] = *(const u32x4*)(src + 8 * jj);
    }
    f32x4 g0[4], g1[4];
#pragma unroll
    for (int jj = 0; jj < 4; ++jj) { g0[jj] = *(const f32x4*)(gain + 32 * qt + 8 * jj); g1[jj] = *(const f32x4*)(gain + 32 * qt + 8 * jj + 4); }
    const int ttA = wave >> 2, ttB = 3 - (wave >> 2);
    bf16x8 wbA[4], wbB[8];
    {   const bf16* wrA = Wt + (size_t)(32 * ttA + tl) * 128 + 8 * h; const bf16* wrB = Wt + (size_t)(32 * ttB + tl) * 128 + 8 * h;
#pragma unroll
        for (int ks = 0; ks < 4; ++ks) if (ks < 2 * (ttA + 1)) wbA[ks] = *(const bf16x8*)(wrA + 16 * ks);
#pragma unroll
        for (int ks = 0; ks < 8; ++ks) if (ks < 2 * (ttB + 1)) wbB[ks] = *(const bf16x8*)(wrB + 16 * ks);
    }
    u32x2 uw[2][2][4]; float bs[2];
    bs[0] = bias[32 * ttA + tl]; bs[1] = bias[32 * ttB + tl];
#pragma unroll
    for (int uu = 0; uu < 2; ++uu)
#pragma unroll
        for (int hf = 0; hf < 2; ++hf) {
            const size_t r = (size_t)((u0 + 256 * uu) >> 2) * 128 + 32 * (hf == 0 ? ttA : ttB) + tl;
#pragma unroll
            for (int i4 = 0; i4 < 4; ++i4) uw[uu][hf][i4] = *(const u32x2*)(Z + r * NIN + C_U + gg * 128 + 32 * ct + 8 * i4 + 4 * h);
        }
    __syncthreads();
#pragma unroll
    for (int uu = 0; uu < 2; ++uu) {
        const float rv = rsqrtf(sv[uu] * (1.0f / 512.0f) + EPS);
#pragma unroll
        for (int jj = 0; jj < 4; ++jj) {
            const u32x4 w = vt[uu][jj];
            u32x4 o;
            o.x = pk2(bflo(w.x) * rv * g0[jj][0], bfhi(w.x) * rv * g0[jj][1]); o.y = pk2(bflo(w.y) * rv * g0[jj][2], bfhi(w.y) * rv * g0[jj][3]);
            o.z = pk2(bflo(w.z) * rv * g1[jj][0], bfhi(w.z) * rv * g1[jj][1]); o.w = pk2(bflo(w.w) * rv * g1[jj][2], bfhi(w.w) * rv * g1[jj][3]);
            *(LAS u32x4*)(lds + uu * (128 * GP) + row * GP + (32 * qt + 8 * jj) * 2) = o;
        }
    }
    __syncthreads();
    const int i16 = lane & 15, tq_ = i16 >> 2, tp = i16 & 3, blk = (lane >> 4) & 1;
    const int traddr = (8 * h + tq_) * GP + (32 * ct + 16 * blk + 4 * tp) * 2;
#pragma unroll
    for (int uu = 0; uu < 2; ++uu)
#pragma unroll
        for (int hf = 0; hf < 2; ++hf) {
            const int tt = hf == 0 ? ttA : ttB;
            const LAS unsigned char* tile = lds + uu * (128 * GP);
            f32x16 acc;
#pragma unroll
            for (int i = 0; i < 16; ++i) acc[i] = 0.f;
            if (hf == 0) {
#pragma unroll
                for (int ks = 0; ks < 4; ++ks) if (ks < 2 * (tt + 1)) {
                    const s16x4 a0 = tr_read(tile + traddr + (16 * ks) * GP), a1 = tr_read(tile + traddr + (16 * ks + 4) * GP);
                    acc = MFMA32(__builtin_shufflevector(a0, a1, 0, 1, 2, 3, 4, 5, 6, 7), wbA[ks], acc);
                }
            } else {
#pragma unroll
                for (int ks = 0; ks < 8; ++ks) if (ks < 2 * (tt + 1)) {
                    const s16x4 a0 = tr_read(tile + traddr + (16 * ks) * GP), a1 = tr_read(tile + traddr + (16 * ks + 4) * GP);
                    acc = MFMA32(__builtin_shufflevector(a0, a1, 0, 1, 2, 3, 4, 5, 6, 7), wbB[ks], acc);
                }
            }
            const size_t r = (size_t)((u0 + 256 * uu) >> 2) * 128 + 32 * tt + tl;
            const float b_ = bs[hf];
#pragma unroll
            for (int i4 = 0; i4 < 4; ++i4) {
                const int c = 32 * ct + 8 * i4 + 4 * h;
                const u32x2 uv = uw[uu][hf][i4];
                const float z0 = (acc[4 * i4] + b_) * bflo(uv.x), z1 = (acc[4 * i4 + 1] + b_) * bfhi(uv.x), z2 = (acc[4 * i4 + 2] + b_) * bflo(uv.y), z3 = (acc[4 * i4 + 3] + b_) * bfhi(uv.y);
                *(u32x2*)(AS + r * 512 + gg * 128 + c) = (u32x2){pk2(z0, z1), pk2(z2, z3)};
            }
        }
}
__device__ __forceinline__ void gmlp_sample_unit(const Args& a, const bf16* Z, bf16* AS, const float* ssv, int layer, int b, int tid) {
    const int c = tid, gg = c >> 7;
    const float gain = a.in[11][layer * 512 + c];
    const float* Wf = a.in[12] + (size_t)(layer * 4 + gg) * 128 * 128;
    const float* bias = a.in[13] + (layer * 4 + gg) * 128;
    float vn[4];
#pragma unroll
    for (int j = 0; j < 4; ++j) {
        const size_t row = (size_t)MP + b * DS + j;
        const float rv = rsqrtf(ssv[row] * (1.0f / 512.0f) + EPS);
        vn[j] = bflo((unsigned)Z[row * NIN + C_VS + c]) * rv * gain;
        a.out[O_GV + ((size_t)(layer * DB + b) * DS + j) * 512 + c] = vn[j];
    }
#pragma unroll
    for (int j = 0; j < 4; ++j) {
        const size_t row = (size_t)MP + b * DS + j;
        float z = bias[j];
#pragma unroll
        for (int s = 0; s < 4; ++s) if (s <= j) z = fmaf(Wf[j * 128 + s], vn[s], z);
        const float uu = bflo((unsigned)Z[row * NIN + C_U + c]);
        AS[row * 512 + c] = (bf16)f2bf(uu * z);
    }
}

__device__ __forceinline__ void phase_mixer(const Args& a, int layer, LAS unsigned char* lds, int tid, int wave, int lane) {
    const bf16* Z = (const bf16*)(a.ws + WS_Z); bf16* AT = (bf16*)(a.ws + WS_ATT); bf16* SP = (bf16*)(a.ws + WS_SP);
    const float* ssv = (const float*)(a.ws + WS_SS) + (7 + layer) * MPAD;
    const int G = gridDim.x, wg = blockIdx.x;
#ifndef MX_MASK
#define MX_MASK 15
#endif
    if (MX_MASK & 1) for (int tk = wg * NWAVES + wave; tk < 2048; tk += G * NWAVES) { const int task = (G == 256) ? ((wg & 7) * 256 + (wg >> 3) * NWAVES + wave) : tk; attn_prompt_task(Z, (const bf16*)(a.ws + WS_KC), (const bf16*)(a.ws + WS_VC), AT, task, lds + wave * ATT_WAVE_LDS, lane); }
    if (MX_MASK & 2) for (int base = wg * 2; base < 512; base += G * 2) {
        LAS float* part = (LAS float*)(lds + 98304);
        if (wave < 6) attn_sample_unit(a, Z, layer, base + wave / 3, wave % 3, (LAS float*)(lds + wave * ATT_WAVE_LDS), part + wave * 72, lane);
        __syncthreads();
        if (tid < 128) attn_sample_combine(AT, base + (tid >> 6), part + (tid >> 6) * 216, tid & 63);
    }
    if (MX_MASK & 4) { if (G == 256) gmlp_prompt_pair(a, Z, SP, ssv, layer, wg, lds, tid, wave, lane); else for (int unit = wg; unit < 512; unit += G) gmlp_prompt_unit(a, Z, SP, ssv, layer, unit, lds, tid, wave, lane); }
    if (MX_MASK & 8) for (int b = G - 1 - wg; b < DB; b += G) gmlp_sample_unit(a, Z, SP, ssv, layer, b, tid);
}

#define MFMA16(a, b, c) __builtin_amdgcn_mfma_f32_16x16x32_bf16((a), (b), (c), 0, 0, 0)
__device__ __forceinline__ void skinny_partial(const bf16* A, const bf16* Bt, int K, int r0, int n0, int wave, int lane, f32x4& acc0, f32x4& acc1) {
    const int ksl = K >> 3, nst = ksl >> 5;
    const bf16* ap = A + (size_t)(r0 + (lane & 15)) * K + wave * ksl + 8 * (lane >> 4);
    const bf16* bp0 = Bt + (size_t)(n0 + (lane & 15)) * K + wave * ksl + 8 * (lane >> 4);
    const bf16* bp1 = bp0 + (size_t)16 * K;
#pragma unroll 1
    for (int s0 = 0; s0 < nst; s0 += 6) {
        bf16x8 av[6], b0[6], b1[6];
#pragma unroll
        for (int u = 0; u < 6; ++u) if (s0 + u < nst) { av[u] = *(const bf16x8*)(ap + 32 * (s0 + u)); b0[u] = *(const bf16x8*)(bp0 + 32 * (s0 + u)); b1[u] = *(const bf16x8*)(bp1 + 32 * (s0 + u)); }
#pragma unroll
        for (int u = 0; u < 6; ++u) if (s0 + u < nst) { acc0 = MFMA16(b0[u], av[u], acc0); acc1 = MFMA16(b1[u], av[u], acc1); }
    }
}
template <int MODE> __device__ __forceinline__ void skinny_phase(LAS unsigned char* lds, const bf16* A, const bf16* Bt, int K, const bf16* A2, const bf16* Bt2, int K2,
                                                                  const float* XinS  , bf16* XB, float* ssn, float alpha, bf16* MIX, const bf16* Z, int tid, int wave, int lane) {
    LAS float* red = (LAS float*)lds;
    const int G = gridDim.x;
    for (int piece = blockIdx.x; piece < 256; piece += G) {
        const int rb = piece >> 5, cb = piece & 31, r0 = MP + 16 * rb, n0 = 32 * cb;
        __syncthreads();
        f32x4 a0 = (f32x4){0.f, 0.f, 0.f, 0.f}, a1 = a0;
        skinny_partial(A, Bt, K, r0, n0, wave, lane, a0, a1);
        *(LAS f32x4*)(red + wave * 512 + lane * 8) = a0; *(LAS f32x4*)(red + wave * 512 + lane * 8 + 4) = a1;
        if (MODE == 1) {
            f32x4 c0 = (f32x4){0.f, 0.f, 0.f, 0.f}, c1 = c0;
            skinny_partial(A2, Bt2, K2, r0, n0, wave, lane, c0, c1);
            *(LAS f32x4*)(red + 4096 + wave * 512 + lane * 8) = c0; *(LAS f32x4*)(red + 4096 + wave * 512 + lane * 8 + 4) = c1;
        }
        __syncthreads();
        const int m = tid >> 5, c = tid & 31, e = (((c & 15) >> 2) * 16 + m) * 8 + (c >> 4) * 4 + (c & 3);
        float s1 = 0.f, s2 = 0.f;
#pragma unroll
        for (int w = 0; w < 8; ++w) { s1 += red[w * 512 + e]; if (MODE == 1) s2 += red[4096 + w * 512 + e]; }
        const size_t row = (size_t)r0 + m; const int col = n0 + c;
        if (MODE == 0) {
            const float x = (XinS ? XinS[(size_t)(16 * rb + m) * DM + col] : bflo((unsigned)XB[row * DM + col])) + alpha * s1;
            XB[row * DM + col] = (bf16)f2bf(x);
            float q = x * x;
            q += __shfl_xor(q, 1); q += __shfl_xor(q, 2); q += __shfl_xor(q, 4); q += __shfl_xor(q, 8); q += __shfl_xor(q, 16);
            if (c == 0) unsafeAtomicAdd(ssn + row, q);
        } else {
            const float ga = bflo((unsigned)Z[row * NIN + C_GA + col]), gb = bflo((unsigned)Z[row * NIN + C_GB + col]);
            MIX[row * DM + col] = (bf16)f2bf(ga * s1 + gb * s2);
        }
    }
}

__device__ __forceinline__ void phase_final(const Args& a, int gw, int NGW, int lane) {
    const bf16* XB = (const bf16*)(a.ws + WS_XB); const float* ss = (const float*)(a.ws + WS_SS) + 6 * MPAD; const float* gain = a.in[21];
    const int mlo = ((int)gridDim.x == (MP / 256) * (DM / 256)) ? MP : 0;
    for (int m = mlo + gw; m < MR; m += NGW) {
        const float r = rsqrtf(ss[m] * (1.0f / DM) + EPS);
#pragma unroll
        for (int j = 0; j < 4; ++j) { const u32x2 w = *(const u32x2*)(XB + (size_t)m * DM + 4 * lane + 256 * j); const f32x4 v = (f32x4){bflo(w.x), bfhi(w.x), bflo(w.y), bfhi(w.y)}, g = *(const f32x4*)(gain + 4 * lane + 256 * j);
            *(f32x4*)(a.out + (size_t)m * DM + 4 * lane + 256 * j) = v * r * g; }
    }
}

constexpr int N_PHASES = 18;
#ifndef MK_MASK
#define MK_MASK 0xFFFF
#endif
#ifndef PJ_MASK
#define PJ_MASK 3
#endif
template <int PH> __device__ __forceinline__ void run_phase(const Args& a, LAS unsigned char* lds) {
    int tid_ = threadIdx.x; asm volatile("" : "+v"(tid_));
    const int tid = tid_, lane = tid & 63, wave = __builtin_amdgcn_readfirstlane(tid >> 6);
    const int G = gridDim.x, wg = blockIdx.x;
    const int gw = wg * NWAVES + wave, NGW = G * NWAVES;
    unsigned char* ws = a.ws;
    float* SS = (float*)(ws + WS_SS);
    float* X = (float*)(ws + WS_X); bf16* XB = (bf16*)(ws + WS_XB); bf16* Zb = (bf16*)(ws + WS_Z); bf16* HB = (bf16*)(ws + WS_Z);
    bf16* ATb = (bf16*)(ws + WS_ATT); bf16* SPb = (bf16*)(ws + WS_SP); bf16* MIX = (bf16*)(ws + WS_MIX);
    if constexpr (PH == 0) { if (MK_MASK & 1) phase_prologue(a, lds, gw, NGW, lane, wave); }
    else if constexpr (PH == N_PHASES - 1) { if (MK_MASK & 2) phase_final(a, gw, NGW, lane); }
    else {
        constexpr int layer = (PH - 1) >> 3, sub = (PH - 1) & 7;
        unsigned char* wl = ws + WS_W + (size_t)layer * WL_STRIDE;
        pg8::StaticOrder S;
        if constexpr (sub == 0 || sub == 6) {
            if (MK_MASK & 4) {
            pg8::Gemm g{XB, (const bf16*)(wl + (sub == 0 ? WL_GU1 : WL_GU2)), MPAD, NGU, DM}; S.init(MPAD, NGU, G, wg);
            EpiGU E{HB, SS + (3 * layer + (sub == 0 ? 0 : 2)) * MPAD};
            pg8::gemm_phase<EpiGU, pg8::StaticOrder, true, true>(lds, g, S, E); }
        } else if constexpr (sub == 1 || sub == 7) {
            if (MK_MASK & 8) {
            pg8::Gemm g{HB, (const bf16*)(wl + (sub == 1 ? WL_DN1 : WL_DN2)), MP, DM, DFF}; S.init(MP, DM, G, wg);
            if constexpr (PH == N_PHASES - 2) {
                if (G * 1 == (MP / 256) * (DM / 256)) { EpiResFinal E{XB, a.out, SS + 6 * MPAD, (unsigned*)(ws + WS_PCNT), a.in[21], 0.5f}; pg8::gemm_phase<EpiResFinal, pg8::StaticOrder, true, true>(lds, g, S, E); }
                else { EpiResT<false> E{nullptr, XB, SS + 6 * MPAD, 0.5f}; pg8::gemm_phase<EpiResT<false>, pg8::StaticOrder, true, true>(lds, g, S, E); }
            } else {
            EpiResT<PH == 2> E{a.in[0], XB, SS + (3 * layer + (sub == 1 ? 1 : 3)) * MPAD, 0.5f};
            pg8::gemm_phase<EpiResT<PH == 2>, pg8::StaticOrder, true, true>(lds, g, S, E); }
            skinny_phase<0>(lds, HB, (const bf16*)(wl + (sub == 1 ? WL_DN1 : WL_DN2)), DFF, nullptr, nullptr, 0, PH == 2 ? a.in[1] : nullptr, XB, SS + (3 * layer + (sub == 1 ? 1 : 3)) * MPAD, 0.5f, nullptr, nullptr, tid, wave, lane); }
        } else if constexpr (sub == 2) {
            if (MK_MASK & 16) {
            pg8::Gemm g{XB, (const bf16*)(wl + WL_IN), MPAD, NIN, DM}; S.init(MPAD, NIN, G, wg);
            EpiIn E{Zb, SS + (3 * layer + 1) * MPAD, SS + (7 + layer) * MPAD, a.out, layer, (bf16*)(ws + WS_KC), (bf16*)(ws + WS_VC)};
            pg8::gemm_phase<EpiIn, pg8::StaticOrder, true, true>(lds, g, S, E); }
        } else if constexpr (sub == 3) {
            if (MK_MASK & 32) phase_mixer(a, layer, lds, tid, wave, lane);
        } else if constexpr (sub == 4) {
            if (MK_MASK & 64) {
            S.init(MP, DM, G, wg);
            if (PJ_MASK & 1) { pg8::Gemm g{ATb, (const bf16*)(wl + WL_PA), MP, DM, 256}; EpiProj<0> E{MIX, Zb}; pg8::gemm_phase<EpiProj<0>, pg8::StaticOrder, true, true>(lds, g, S, E); }
            __syncthreads();
            if (PJ_MASK & 2) { pg8::Gemm g{SPb, (const bf16*)(wl + WL_PS), MP, DM, 512}; EpiProj<1> E{MIX, Zb}; pg8::gemm_phase<EpiProj<1>, pg8::StaticOrder, true, true>(lds, g, S, E); }
            skinny_phase<1>(lds, ATb, (const bf16*)(wl + WL_PA), 256, SPb, (const bf16*)(wl + WL_PS), 512, nullptr, nullptr, nullptr, 0.f, MIX, Zb, tid, wave, lane); }
        } else {
            if (MK_MASK & 128) {
            pg8::Gemm g{MIX, (const bf16*)(wl + WL_WO), MP, DM, DM}; S.init(MP, DM, G, wg);
            EpiResT<false> E{nullptr, XB, SS + (3 * layer + 2) * MPAD, 1.0f};
            pg8::gemm_phase<EpiResT<false>, pg8::StaticOrder, true, true>(lds, g, S, E);
            skinny_phase<0>(lds, MIX, (const bf16*)(wl + WL_WO), DM, nullptr, nullptr, 0, nullptr, XB, SS + (3 * layer + 2) * MPAD, 1.0f, nullptr, nullptr, tid, wave, lane); }
        }
    }
}
template <int PH> __device__ __forceinline__ void run_from(const Args& a, LAS unsigned char* lds, int ph_lo, int ph_hi, const XcdBarrier& bar) {
    if constexpr (PH < N_PHASES) {
        if (ph_lo <= PH && PH < ph_hi) {
            if (PH > ph_lo) xcd_barrier(bar);
            run_phase<PH>(a, lds);
#ifndef PROBE_REP
#define PROBE_REP 0
#endif
            { constexpr int sub_ = (PH - 1) & 7; constexpr bool mid_ = PH > 0 && PH < N_PHASES - 1;
              if ((PH == 0 && (PROBE_REP & 1)) || (mid_ && (sub_ == 0 || sub_ == 6) && (PROBE_REP & 4)) || (mid_ && sub_ == 3 && (PROBE_REP & 32)) || (mid_ && sub_ == 4 && (PROBE_REP & 64))) { __syncthreads(); run_phase<PH>(a, lds); } }
        }
        run_from<PH + 1>(a, lds, ph_lo, ph_hi, bar);
    }
}
__global__ void __launch_bounds__(NTHR, 2) mk_fwd(Args a) {
    extern __shared__ __attribute__((aligned(16))) unsigned char lds_raw[];
    LAS unsigned char* lds = (LAS unsigned char*)lds_raw;
    if (a.ph_lo < 0) cg::this_grid().sync();
    if (threadIdx.x < 2) ((volatile LAS unsigned*)(lds + LDS_MISC))[threadIdx.x] = 0u;
    __syncthreads();
    XcdBarrier bar; bar.bar = (unsigned*)(a.ws + WS_BAR); bar.x = 0; bar.st = (volatile LAS unsigned*)(lds + LDS_MISC);
    if (a.ph_hi - a.ph_lo > 1) bar = xcd_barrier_post((unsigned*)(a.ws + WS_BAR), (volatile LAS unsigned*)(lds + LDS_MISC));
    run_from<0>(a, lds, a.ph_lo, a.ph_hi, bar);
}

#ifndef MK_MULTI
#define MK_MULTI 0
#endif
extern "C" void kernel_launch(void* const* d_in, const int* in_sizes, int n_in, void* d_out, int out_size, void* d_ws, size_t ws_size, hipStream_t stream) {
    static int grid = 0;
    if (grid == 0) {
        if (n_in != 22 || (size_t)out_size != O_TOTAL || ws_size < WS_END) { fprintf(stderr, "kernel_launch: unexpected shapes n_in %d out %d ws %zu (need %zu)\n", n_in, out_size, ws_size, (size_t)WS_END); grid = -1; return; }
        int dev = 0, cus = 0, per_cu = 0;
        hipGetDevice(&dev); hipDeviceGetAttribute(&cus, hipDeviceAttributeMultiprocessorCount, dev);
        if (hipFuncSetAttribute((const void*)mk_fwd, hipFuncAttributeMaxDynamicSharedMemorySize, LDS_BYTES) != hipSuccess) { fprintf(stderr, "kernel_launch: hipFuncSetAttribute failed\n"); grid = -1; return; }
        if (hipOccupancyMaxActiveBlocksPerMultiprocessor(&per_cu, (const void*)mk_fwd, NTHR, LDS_BYTES) != hipSuccess || per_cu < 1) { fprintf(stderr, "kernel_launch: occupancy query failed (%d)\n", per_cu); (void)hipGetLastError(); per_cu = 1; }
        grid = cus * 1;
        if (per_cu < 1) grid = -1;
    }
    if (grid < 0) return;
    if (hipMemsetAsync((char*)d_ws + WS_CTL0, 0, WS_CTL_BYTES, stream) != hipSuccess) { fprintf(stderr, "kernel_launch: hipMemsetAsync failed\n"); return; }
    Args a{};
    for (int i = 0; i < 22; ++i) a.in[i] = (const float*)d_in[i];
    a.out = (float*)d_out; a.ws = (unsigned char*)d_ws;
#if MK_MULTI
    for (int ph = 0; ph < N_PHASES; ++ph) { a.ph_lo = ph; a.ph_hi = ph + 1; hipLaunchKernelGGL(mk_fwd, dim3(grid), dim3(NTHR), LDS_BYTES, stream, a); }
#else
    a.ph_lo = 0; a.ph_hi = N_PHASES;
    void* args[] = {&a};
    hipError_t e = hipLaunchCooperativeKernel((const void*)mk_fwd, dim3(grid), dim3(NTHR), args, LDS_BYTES, stream);
    if (e != hipSuccess) fprintf(stderr, "cooperative launch failed: %s (grid %d)\n", hipGetErrorString(e), grid);
#endif
}
```
